# Optimizing an MI355X kernel written in HIP

```python
import math
import jax, jax.numpy as jnp
from jax import lax
import numpy as np

D_MODEL = 2048
BATCH = 4
SEQ = 2048
DEPTH = 1
DEC_BATCH = 32
DEC_SEQ = 16
PAST_LEN = 2048

CHUNK = 64
N_HEADS = 8
D_QK = 64
D_V = 2 * D_QK
ATT_W = N_HEADS * D_V
CONV_W = D_MODEL // 2
CONV_K = 3
NUM_BUCKETS = 32
MAX_DISTANCE = 128
Q_BLOCK = 128
EPS = 1e-6
SPLIT_SIZES = (N_HEADS * 2 * D_QK,
               N_HEADS * 2 * D_QK,
               ATT_W,
               ATT_W,
               CONV_W,
               CONV_W,
               CONV_W,
               CONV_W,
               D_MODEL,
               D_MODEL)
N_IN = sum(SPLIT_SIZES)
SPLIT_IDX = tuple(int(i) for i in np.cumsum(SPLIT_SIZES)[:-1])

kernel_name = "hybrid_diffattn_shortconv_stream_step"


def rmsnorm(x, g):
    xf = x.astype(jnp.float32)
    xf = xf * lax.rsqrt(jnp.mean(xf * xf, axis=-1, keepdims=True) + EPS)
    return xf.astype(x.dtype) * g


def rel_bucket(rel):
    half = NUM_BUCKETS // 2
    max_exact = half // 2
    ret = (rel > 0).astype(jnp.int32) * half
    n = jnp.abs(rel)
    nf = jnp.maximum(n, 1).astype(jnp.float32)
    large = max_exact + (jnp.log(nf / max_exact) / math.log(MAX_DISTANCE / max_exact)
                         * (half - max_exact)).astype(jnp.int32)
    large = jnp.minimum(large, half - 1)
    return ret + jnp.where(n < max_exact, n, large)


def diff_attend(q, k, v, qpos, kpos, lam, rel_bias):
    bias = rel_bias[rel_bucket(kpos[None, :] - qpos[:, None])]
    bias = jnp.transpose(bias, (2, 0, 1)).astype(jnp.float32)
    mask = (kpos[None, :] // CHUNK) <= (qpos[:, None] // CHUNK)
    scale = 1.0 / math.sqrt(D_QK)

    def probs(qa, ka):
        s = jnp.einsum('bqhd,bkhd->bhqk', qa, ka).astype(jnp.float32) * scale + bias
        s = jnp.where(mask, s, jnp.finfo(jnp.float32).min)
        return jax.nn.softmax(s, axis=-1)

    a = probs(q[..., :D_QK], k[..., :D_QK]) - lam * probs(q[..., D_QK:], k[..., D_QK:])
    return jnp.einsum('bhqk,bkhe->bqhe', a.astype(v.dtype), v)


def attend_prompt(q, k, v, lam, rel_bias):
    b, t = q.shape[0], q.shape[1]
    nb = t // Q_BLOCK
    qb = q.reshape(b, nb, Q_BLOCK, N_HEADS, 2 * D_QK).transpose(1, 0, 2, 3, 4)
    starts = jnp.arange(nb, dtype=jnp.int32) * Q_BLOCK
    kpos = jnp.arange(t, dtype=jnp.int32)

    def blk(args):
        qi, s0 = args
        qpos = s0 + jnp.arange(Q_BLOCK, dtype=jnp.int32)
        return diff_attend(qi, k, v, qpos, kpos, lam, rel_bias)

    o = lax.map(blk, (qb, starts))
    return o.transpose(1, 0, 2, 3, 4).reshape(b, t, N_HEADS, D_V)


def short_conv(u, state, w):
    t = u.shape[1]
    p = jnp.concatenate([state, u], axis=1)
    y = w[0] * p[:, 0:t] + w[1] * p[:, 1:t + 1] + w[2] * p[:, 2:t + 2]
    return y, p[:, -(CONV_K - 1):]


def mixer_layer(x, past_k, past_v, conv_state, is_prompt, lam, lam_init,
                norm_pre, norm_post, w_in, head_norm, conv_w,
                w_proj_attn, w_proj_conv, w_out, rel_bias):
    b, t, _ = x.shape
    xn = rmsnorm(x, norm_pre)
    p = jnp.einsum('btd,dn->btn', xn, w_in)
    q, k, v, za, bg, cg, h, zc, ga, gc = jnp.split(p, SPLIT_IDX, axis=-1)
    q = q.reshape(b, t, N_HEADS, 2 * D_QK)
    k = k.reshape(b, t, N_HEADS, 2 * D_QK)
    v = v.reshape(b, t, N_HEADS, D_V)
    if is_prompt:
        o = attend_prompt(q, k, v, lam, rel_bias)
    else:
        k_all = jnp.concatenate([past_k, k], axis=1)
        v_all = jnp.concatenate([past_v, v], axis=1)
        past = past_k.shape[1]
        qpos = past + jnp.arange(t, dtype=jnp.int32)
        kpos = jnp.arange(past + t, dtype=jnp.int32)
        o = diff_attend(q, k_all, v_all, qpos, kpos, lam, rel_bias)
    o = rmsnorm(o, head_norm) * (1.0 - lam_init)
    ya = jnp.einsum('bte,ed->btd', o.reshape(b, t, ATT_W) * jax.nn.silu(za), w_proj_attn)
    yc, new_conv = short_conv(cg * h, conv_state, conv_w)
    yc = jnp.einsum('btc,cd->btd', bg * yc * jax.nn.silu(zc), w_proj_conv)
    y = jnp.einsum('btd,de->bte', jax.nn.sigmoid(ga) * ya + jax.nn.sigmoid(gc) * yc, w_out)
    return x + rmsnorm(y, norm_post), k, v, new_conv


def setup_inputs(seed: int = 0) -> dict:
    key = jax.random.key(seed)
    ks = jax.random.split(key, 20)
    f32 = jnp.float32
    nrm = lambda k, s, sc: jax.random.normal(k, s, f32) * sc
    return {
        "x_prompt": nrm(ks[0], (BATCH, SEQ, D_MODEL), 1.0),
        "x_sample": nrm(ks[1], (DEC_BATCH, DEC_SEQ, D_MODEL), 1.0),
        "cache_k": nrm(ks[2], (DEPTH, DEC_BATCH, PAST_LEN, N_HEADS, 2 * D_QK), 1.0),
        "cache_v": nrm(ks[3], (DEPTH, DEC_BATCH, PAST_LEN, N_HEADS, D_V), 1.0),
        "state_conv": nrm(ks[4], (DEPTH, DEC_BATCH, CONV_K - 1, CONV_W), 1.0),
        "norm_pre": 1.0 + nrm(ks[5], (DEPTH, D_MODEL), 0.02),
        "norm_post": 1.0 + nrm(ks[6], (DEPTH, D_MODEL), 0.02),
        "w_in": nrm(ks[7], (DEPTH, D_MODEL, N_IN), D_MODEL ** -0.5),
        "lambda_q1": nrm(ks[8], (DEPTH, D_QK), 0.1),
        "lambda_k1": nrm(ks[9], (DEPTH, D_QK), 0.1),
        "lambda_q2": nrm(ks[10], (DEPTH, D_QK), 0.1),
        "lambda_k2": nrm(ks[11], (DEPTH, D_QK), 0.1),
        "head_norm": 1.0 + nrm(ks[12], (DEPTH, D_V), 0.02),
        "conv_w": nrm(ks[13], (DEPTH, CONV_K, CONV_W), CONV_K ** -0.5),
        "w_proj_attn": nrm(ks[14], (DEPTH, ATT_W, D_MODEL), ATT_W ** -0.5),
        "w_proj_conv": nrm(ks[15], (DEPTH, CONV_W, D_MODEL), CONV_W ** -0.5),
        "w_out": nrm(ks[16], (DEPTH, D_MODEL, D_MODEL), D_MODEL ** -0.5),
        "rel_bias": nrm(ks[17], (NUM_BUCKETS, N_HEADS), 0.5),
    }


def reference(x_prompt, x_sample, cache_k, cache_v, state_conv, norm_pre, norm_post,
              w_in, lambda_q1, lambda_k1, lambda_q2, lambda_k2, head_norm, conv_w,
              w_proj_attn, w_proj_conv, w_out, rel_bias):
    xp, xs = x_prompt, x_sample
    kp_l, vp_l, cp_l, ks_l, vs_l, cs_l = [], [], [], [], [], []
    zero_conv = jnp.zeros((xp.shape[0], CONV_K - 1, CONV_W), xp.dtype)
    for l in range(DEPTH):
        lam_init = 0.8 - 0.6 * math.exp(-0.3 * l)
        lam = (jnp.exp(jnp.sum(lambda_q1[l].astype(jnp.float32) * lambda_k1[l].astype(jnp.float32)))
               - jnp.exp(jnp.sum(lambda_q2[l].astype(jnp.float32) * lambda_k2[l].astype(jnp.float32)))
               + lam_init)
        weights = (norm_pre[l], norm_post[l], w_in[l], head_norm[l], conv_w[l],
                   w_proj_attn[l], w_proj_conv[l], w_out[l], rel_bias)
        xp, kp, vp, cp = mixer_layer(xp, None, None, zero_conv, True, lam, lam_init, *weights)
        xs, ksm, vsm, csm = mixer_layer(xs, cache_k[l], cache_v[l], state_conv[l], False,
                                        lam, lam_init, *weights)
        kp_l.append(kp); vp_l.append(vp); cp_l.append(cp)
        ks_l.append(ksm); vs_l.append(vsm); cs_l.append(csm)
    new_k_prompt = jnp.stack(kp_l, axis=0)
    new_v_prompt = jnp.stack(vp_l, axis=0)
    new_conv_prompt = jnp.stack(cp_l, axis=0)
    new_k_sample = jnp.stack(ks_l, axis=0)
    new_v_sample = jnp.stack(vs_l, axis=0)
    new_conv_sample = jnp.stack(cs_l, axis=0)
    return (xp, xs, new_k_prompt, new_v_prompt, new_conv_prompt,
            new_k_sample, new_v_sample, new_conv_sample)
```

```cpp
#include <hip/hip_runtime.h>
#include <cstdio>
#include <cstdint>

#ifndef MK_N_LAUNCHES
#define MK_N_LAUNCHES 1
#endif
#define PROBE_LO -1
#define PROBE_HI -1
#define PROBE_MODE 0

constexpr int D_MODEL = 2048, BATCH = 4, SEQ = 2048, DEC_BATCH = 32, DEC_SEQ = 16, PAST = 2048, NH = 8, DQK = 64, DV = 128, ATT_W = 1024, CONV_W = 1024, N_IN = 12288;
constexpr int MP = BATCH * SEQ, MS = DEC_BATCH * DEC_SEQ, M = MP + MS;
constexpr float EPS = 1e-6f, LOG2E = 1.4426950408889634f, QSCALE = 0.125f * LOG2E, LAM_INIT = 0.2f;
constexpr size_t O_YP = 0, O_YS = O_YP + (size_t)MP * D_MODEL, O_KP = O_YS + (size_t)MS * D_MODEL, O_VP = O_KP + (size_t)MP * 1024, O_CP = O_VP + (size_t)MP * 1024,
                 O_KS = O_CP + (size_t)BATCH * 2 * CONV_W, O_VS = O_KS + (size_t)MS * 1024, O_CS = O_VS + (size_t)MS * 1024, O_END = O_CS + (size_t)DEC_BATCH * 2 * CONV_W;

constexpr size_t MiB = 1u << 20;
constexpr size_t WS_CTL = 0, CTL_ZERO_BYTES = 1 * MiB;
constexpr size_t WS_W1T = 2 * MiB, WS_W3T = 50 * MiB, WS_W4T = 58 * MiB, WS_XN = 66 * MiB, WS_QB = 100 * MiB, WS_KB = 117 * MiB, WS_VB = 134 * MiB,
                 WS_A3 = 151 * MiB, WS_U = 185 * MiB, WS_RB = 202 * MiB, WS_S2 = 236 * MiB, WS_MB = 270 * MiB, WS_Y = 304 * MiB, WS_SST = 372 * MiB, WS_END = 384 * MiB;
constexpr int CW_TMO = 0, CW_SREADY = 64, CW_BAR = 4096;

constexpr int RING_BYTES = 131072, LDSCTL_OFF = RING_BYTES, MISC_OFF = LDSCTL_OFF + 320, TAB_OFF = LDSCTL_OFF + 512, HN_OFF = TAB_OFF + 1024, LDS_BYTES = 147456;
constexpr int NWAVES = 8;

#define GAS __attribute__((address_space(1)))
#define LAS __attribute__((address_space(3)))
typedef unsigned short bf16_t;
typedef short bf16x8 __attribute__((ext_vector_type(8)));
typedef short s16x4 __attribute__((ext_vector_type(4)));
typedef float f32x4 __attribute__((ext_vector_type(4)));
typedef float f32x16 __attribute__((ext_vector_type(16)));
typedef unsigned u32x4 __attribute__((ext_vector_type(4)));
typedef unsigned u32x2 __attribute__((ext_vector_type(2)));
typedef float f32x2_t __attribute__((ext_vector_type(2)));
typedef __bf16 bf16x2_t __attribute__((ext_vector_type(2)));
typedef GAS unsigned gu32;
#define RLX_AGENT __ATOMIC_RELAXED, __HIP_MEMORY_SCOPE_AGENT
#define LDS_WAIT() asm volatile("s_waitcnt lgkmcnt(0)" ::: "memory")
#define VM_WAIT() asm volatile("s_waitcnt vmcnt(0)" ::: "memory")

__device__ __forceinline__ unsigned pk_bf16(float lo, float hi) { f32x2_t v = {lo, hi}; bf16x2_t b = __builtin_convertvector(v, bf16x2_t); return __builtin_bit_cast(unsigned, b); }
__device__ __forceinline__ float bf_lo(unsigned w) { return __uint_as_float(w << 16); }
__device__ __forceinline__ float bf_hi(unsigned w) { return __uint_as_float(w & 0xffff0000u); }
__device__ __forceinline__ float fast_exp2(float x) { return __builtin_amdgcn_exp2f(x); }
__device__ __forceinline__ float fast_rcp(float x) { return __builtin_amdgcn_rcpf(x); }
__device__ __forceinline__ float sigmoidf_(float x) { x = fminf(fmaxf(x, -30.f), 30.f); return fast_rcp(1.f + fast_exp2(-x * LOG2E)); }
__device__ __forceinline__ float siluf_(float x) { return x * sigmoidf_(x); }

__host__ __device__ __forceinline__ int orig_col(int v) {
    if (v < 4096) return v;
    const int vl = v & 255;
    if (v < 8192) { const int j = (v - 4096) >> 8, bj = vl >> 7, wc = (vl >> 5) & 3, fq = (vl >> 3) & 3, n = (vl >> 2) & 1, e = vl & 3; return 4096 + 1024 * (2 * bj + n) + 64 * j + 16 * wc + 4 * fq + e; }
    const int j = (v - 8192) >> 8, bj = vl >> 7; return 8192 + 2048 * bj + 128 * j + (vl & 127);
}

namespace pg8 {
#define PG8_LAS __attribute__((address_space(3)))
constexpr int BM = 256, BK = 64, HALF = 128, HTB = HALF * BK * 2, STAGE_BYTES = 8 * HTB, NXCD = 8, WGM = 8;
__host__ __device__ __forceinline__ int lds_byte(int r, int c) { const int st = (r >> 4) * 2 + (c >> 5), rr = r & 15, cc = c & 31, ob = rr * 64 + cc * 2; return st * 1024 + (ob ^ (((ob >> 9) & 1) << 5)); }
__host__ __device__ __forceinline__ void stage_rc(int b, int& R, int& C) { const int st = b / 1024, sb = b % 1024, swz = sb ^ (((sb >> 9) & 1) << 5); R = (st >> 1) * 16 + swz / 64; C = (st & 1) * 32 + (swz % 64) / 2; }
__host__ __device__ __forceinline__ int perm32(int rho) { const int n = rho >> 4, i = rho & 15; return 8 * (i >> 2) + 4 * n + (i & 3); }
struct Unit { int pm, pn; };
struct Gemm { const bf16_t* A; const bf16_t* Bt; int M, N, K; };
struct StaticOrder {
    int nM, nN, nwg, G, c, limit;
    __host__ __device__ void init(int M_, int N_, int G_, int c_) { nM = M_ / BM; nN = N_ / BM; nwg = nM * nN; G = G_; c = c_; limit = nwg; }
    __host__ __device__ void unit_of(int L, Unit& u) const {
        int wgid = L; { const int q = nwg / NXCD, r = nwg % NXCD, xcd = wgid % NXCD, off = wgid / NXCD; wgid = (xcd < r ? xcd * (q + 1) : r * (q + 1) + (xcd - r) * q) + off; }
        const int nig = WGM * nN, gid = wgid / nig, fm = gid * WGM, gsz = (nM - fm) < WGM ? (nM - fm) : WGM;
        u.pm = fm + ((wgid % nig) % gsz); u.pn = (wgid % nig) / gsz;
    }
    __host__ __device__ bool next(int i, Unit& u) const {
        const long L = (long)i * G + c; if (L >= limit) return false;
        int wgid = (int)L; { const int q = nwg / NXCD, r = nwg % NXCD, xcd = wgid % NXCD, off = wgid / NXCD; wgid = (xcd < r ? xcd * (q + 1) : r * (q + 1) + (xcd - r) * q) + off; }
        const int nig = WGM * nN, gid = wgid / nig, fm = gid * WGM, gsz = (nM - fm) < WGM ? (nM - fm) : WGM;
        u.pm = fm + ((wgid % nig) % gsz); u.pn = (wgid % nig) / gsz; return true;
    }
    __device__ __forceinline__ void a_ready(const Unit&) const {}
    __device__ __forceinline__ void done(const Unit&) const {}
};

struct P1Order {
    StaticOrder base; int G, c; unsigned* cnt;
    __device__ void init(int G_, int c_, unsigned* cnt_) { base.init(8192, 12288, G_, c_); G = G_; c = c_; cnt = cnt_; }
    __device__ bool next(int i, Unit& u) const {
        const long L = (long)i * G + c; if (L >= 96 + base.nwg) return false;
        if (L < 96) { u.pm = 32 + (int)L / 48; u.pn = (int)L % 48; return true; }
        base.unit_of((int)L - 96, u); return true;
    }
    __device__ __forceinline__ void a_ready(const Unit&) const {}
    __device__ __forceinline__ void done(const Unit& u) const {
        if (u.pm >= 32 && u.pn < 16) {
            asm volatile("s_waitcnt vmcnt(0)" ::: "memory");
            __builtin_amdgcn_fence(__ATOMIC_RELEASE, "agent");
            asm volatile("s_waitcnt vmcnt(0)" ::: "memory");
            if ((threadIdx.x & 63) == 0) __hip_atomic_fetch_add(cnt, 1u, __ATOMIC_RELAXED, __HIP_MEMORY_SCOPE_AGENT);
        }
    }
};

struct Epi1 {
    static constexpr bool PERM = true, AFTER_DRAIN = false, HAS_MID = false; static constexpr int MID_T = 0;
    bf16_t *Qb, *Kb, *Vb, *A3, *U, *R, *S2; float* out;
    __device__ __forceinline__ void mid(f32x4 (&)[2][2][4][2], const Unit&, int, int, int, int) const {}
    __device__ __forceinline__ void operator()(const f32x4 (&acc)[2][2][4][2], const Unit& u, int wr, int wc, int fr, int fq) const {
        const int row0 = u.pm * BM + wr * 64 + fr, pn = u.pn, cl = wc * 32 + 8 * fq;
        if (pn < 4) {
#pragma unroll
            for (int ai = 0; ai < 2; ++ai)
#pragma unroll
                for (int m = 0; m < 4; ++m) { bf16_t* rp = Qb + (size_t)(row0 + ai * HALF + m * 16) * 1024 + pn * 256 + cl;
#pragma unroll
                    for (int bj = 0; bj < 2; ++bj) { const f32x4 v0 = acc[ai][bj][m][0] * QSCALE, v1 = acc[ai][bj][m][1] * QSCALE;
                        u32x4 w; w.x = pk_bf16(v0[0], v0[1]); w.y = pk_bf16(v0[2], v0[3]); w.z = pk_bf16(v1[0], v1[1]); w.w = pk_bf16(v1[2], v1[3]); *(u32x4*)(rp + bj * HALF) = w; } }
        } else if (pn < 12) {
            const bool isk = pn < 8; const int ct = (isk ? pn - 4 : pn - 8) * 256 + cl;
            bf16_t* B = isk ? Kb : Vb;
            float* O = (u.pm < MP / BM) ? out + (isk ? O_KP : O_VP) : out + (isk ? O_KS : O_VS) - (size_t)MP * 1024;
#pragma unroll
            for (int ai = 0; ai < 2; ++ai)
#pragma unroll
                for (int m = 0; m < 4; ++m) { const size_t ro = (size_t)(row0 + ai * HALF + m * 16) * 1024 + ct;
#pragma unroll
                    for (int bj = 0; bj < 2; ++bj) { const f32x4 v0 = acc[ai][bj][m][0], v1 = acc[ai][bj][m][1];
                        *(f32x4*)(O + ro + bj * HALF) = v0; *(f32x4*)(O + ro + bj * HALF + 4) = v1;
                        u32x4 w; w.x = pk_bf16(v0[0], v0[1]); w.y = pk_bf16(v0[2], v0[3]); w.z = pk_bf16(v1[0], v1[1]); w.w = pk_bf16(v1[2], v1[3]); *(u32x4*)(B + ro + bj * HALF) = w; } }
        } else if (pn < 16) {
#pragma unroll
            for (int ai = 0; ai < 2; ++ai)
#pragma unroll
                for (int m = 0; m < 4; ++m) { bf16_t* rp = A3 + (size_t)(row0 + ai * HALF + m * 16) * 2048 + (pn - 12) * 256 + cl;
#pragma unroll
                    for (int bj = 0; bj < 2; ++bj) { const f32x4 a = acc[ai][bj][m][0], b = acc[ai][bj][m][1];
                        u32x4 w; w.x = pk_bf16(siluf_(a[0]), siluf_(a[1])); w.y = pk_bf16(siluf_(a[2]), siluf_(a[3])); w.z = pk_bf16(siluf_(b[0]), siluf_(b[1])); w.w = pk_bf16(siluf_(b[2]), siluf_(b[3]));
                        *(u32x4*)(rp + bj * HALF) = w; } }
        } else if (pn < 32) {
            const int ch0 = (pn - 16) * 64 + wc * 16 + 4 * fq;
#pragma unroll
            for (int ai = 0; ai < 2; ++ai)
#pragma unroll
                for (int m = 0; m < 4; ++m) { const size_t row = (size_t)(row0 + ai * HALF + m * 16);
                    const f32x4 bg = acc[ai][0][m][0], cg = acc[ai][0][m][1], hh = acc[ai][1][m][0], zc = acc[ai][1][m][1];
                    const f32x4 uu = cg * hh; u32x2 wu; wu.x = pk_bf16(uu[0], uu[1]); wu.y = pk_bf16(uu[2], uu[3]); *(u32x2*)(U + row * 1024 + ch0) = wu;
                    u32x2 wg; wg.x = pk_bf16(bg[0] * siluf_(zc[0]), bg[1] * siluf_(zc[1])); wg.y = pk_bf16(bg[2] * siluf_(zc[2]), bg[3] * siluf_(zc[3])); *(u32x2*)(A3 + row * 2048 + 1024 + ch0) = wg; }
        } else {
            const int ch0 = (pn - 32) * 128 + cl;
#pragma unroll
            for (int ai = 0; ai < 2; ++ai)
#pragma unroll
                for (int m = 0; m < 4; ++m) { const size_t ro = (size_t)(row0 + ai * HALF + m * 16) * 2048 + ch0; float rr[8], ss[8];
#pragma unroll
                    for (int n = 0; n < 2; ++n)
#pragma unroll
                        for (int e = 0; e < 4; ++e) { const float ga = fminf(fmaxf(acc[ai][0][m][n][e], -30.f), 30.f), gc = fminf(fmaxf(acc[ai][1][m][n][e], -30.f), 30.f);
                            const float ea = 1.f + fast_exp2(-ga * LOG2E), ec = 1.f + fast_exp2(-gc * LOG2E); rr[4 * n + e] = ec * fast_rcp(ea); ss[4 * n + e] = fast_rcp(ec); }
                    u32x4 w; w.x = pk_bf16(rr[0], rr[1]); w.y = pk_bf16(rr[2], rr[3]); w.z = pk_bf16(rr[4], rr[5]); w.w = pk_bf16(rr[6], rr[7]); *(u32x4*)(R + ro) = w;
                    u32x4 s; s.x = pk_bf16(ss[0], ss[1]); s.y = pk_bf16(ss[2], ss[3]); s.z = pk_bf16(ss[4], ss[5]); s.w = pk_bf16(ss[6], ss[7]); *(u32x4*)(S2 + ro) = s; }
        }
    }
};
struct Epi3 {
    static constexpr bool PERM = true, AFTER_DRAIN = false, HAS_MID = true; static constexpr int MID_T = 16;
    const bf16_t *R, *S2; bf16_t* Mb;
    __device__ __forceinline__ void mid(f32x4 (&acc)[2][2][4][2], const Unit& u, int wr, int wc, int fr_, int fq_) const {
        int fr = fr_, fq = fq_; asm volatile("" : "+v"(fr), "+v"(fq));
        const bf16_t* base = R + (size_t)(u.pm * BM + wr * 64 + fr) * 2048 + (u.pn * BM + wc * 32 + 8 * fq);
#pragma unroll
        for (int ai = 0; ai < 2; ++ai)
#pragma unroll
            for (int mp = 0; mp < 2; ++mp) {
#pragma unroll
                for (int mm = 0; mm < 2; ++mm) { const int m = 2 * mp + mm; const bf16_t* rp = base + (size_t)(ai * HALF + m * 16) * 2048;
#pragma unroll
                    for (int bj = 0; bj < 2; ++bj) { const u32x4 w = *(const u32x4*)(rp + bj * HALF);
                        acc[ai][bj][m][0] *= (f32x4){bf_lo(w.x), bf_hi(w.x), bf_lo(w.y), bf_hi(w.y)}; acc[ai][bj][m][1] *= (f32x4){bf_lo(w.z), bf_hi(w.z), bf_lo(w.w), bf_hi(w.w)}; } }
                asm volatile("" ::: "memory"); }
    }
    __device__ __forceinline__ void operator()(const f32x4 (&acc)[2][2][4][2], const Unit& u, int wr, int wc, int fr_, int fq_) const {
        int fr = fr_, fq = fq_; asm volatile("" : "+v"(fr), "+v"(fq));
        const size_t ro0 = (size_t)(u.pm * BM + wr * 64 + fr) * 2048 + (u.pn * BM + wc * 32 + 8 * fq);
#pragma unroll
        for (int ai = 0; ai < 2; ++ai)
#pragma unroll
            for (int mp = 0; mp < 2; ++mp) {
#pragma unroll
                for (int mm = 0; mm < 2; ++mm) { const int m = 2 * mp + mm; const size_t ro = ro0 + (size_t)(ai * HALF + m * 16) * 2048;
#pragma unroll
                    for (int bj = 0; bj < 2; ++bj) { const u32x4 s = *(const u32x4*)(S2 + ro + bj * HALF); const f32x4 a = acc[ai][bj][m][0], b = acc[ai][bj][m][1];
                        u32x4 w; w.x = pk_bf16(a[0] * bf_lo(s.x), a[1] * bf_hi(s.x)); w.y = pk_bf16(a[2] * bf_lo(s.y), a[3] * bf_hi(s.y)); w.z = pk_bf16(b[0] * bf_lo(s.z), b[1] * bf_hi(s.z)); w.w = pk_bf16(b[2] * bf_lo(s.w), b[3] * bf_hi(s.w));
                        *(u32x4*)(Mb + ro + bj * HALF) = w; } }
                asm volatile("" ::: "memory"); }
    }
    __device__ __forceinline__ void tail_mid(f32x4 (&acc)[2], int row, int col) const {
#pragma unroll
        for (int n = 0; n < 2; ++n) { const u32x2 r = *(const u32x2*)(R + (size_t)row * 2048 + col + 16 * n); acc[n] *= (f32x4){bf_lo(r.x), bf_hi(r.x), bf_lo(r.y), bf_hi(r.y)}; }
    }
    __device__ __forceinline__ void tail_out(const f32x4 (&acc)[2], int row, int col) const {
#pragma unroll
        for (int n = 0; n < 2; ++n) { const size_t ro = (size_t)row * 2048 + col + 16 * n; const u32x2 t = *(const u32x2*)(S2 + ro);
            u32x2 w; w.x = pk_bf16(acc[n][0] * bf_lo(t.x), acc[n][1] * bf_hi(t.x)); w.y = pk_bf16(acc[n][2] * bf_lo(t.y), acc[n][3] * bf_hi(t.y)); *(u32x2*)(Mb + ro) = w; }
    }
};
struct EpiY {
    static constexpr bool PERM = true, AFTER_DRAIN = false, HAS_MID = false; static constexpr int MID_T = 0;
    bf16_t* Y;
    __device__ __forceinline__ void mid(f32x4 (&)[2][2][4][2], const Unit&, int, int, int, int) const {}
    __device__ __forceinline__ void operator()(const f32x4 (&acc)[2][2][4][2], const Unit& u, int wr, int wc, int fr, int fq) const {
        const int row0 = u.pm * BM + wr * 64 + fr, col0 = u.pn * BM + wc * 32 + 8 * fq;
#pragma unroll
        for (int ai = 0; ai < 2; ++ai)
#pragma unroll
            for (int m = 0; m < 4; ++m) { bf16_t* rp = Y + (size_t)(row0 + ai * HALF + m * 16) * 2048 + col0;
#pragma unroll
                for (int bj = 0; bj < 2; ++bj) { const f32x4 a = acc[ai][bj][m][0], b = acc[ai][bj][m][1];
                    u32x4 w; w.x = pk_bf16(a[0], a[1]); w.y = pk_bf16(a[2], a[3]); w.z = pk_bf16(b[0], b[1]); w.w = pk_bf16(b[2], b[3]); *(u32x4*)(rp + bj * HALF) = w; } }
    }
    __device__ __forceinline__ void tail_mid(f32x4 (&)[2], int, int) const {}
    __device__ __forceinline__ void tail_out(const f32x4 (&acc)[2], int row, int col) const {
#pragma unroll
        for (int n = 0; n < 2; ++n) { u32x2 w; w.x = pk_bf16(acc[n][0], acc[n][1]); w.y = pk_bf16(acc[n][2], acc[n][3]); *(u32x2*)(Y + (size_t)row * 2048 + col + 16 * n) = w; }
    }
};

template <class Epi, class Sched, bool ALIGN_EPI = false, bool SP2 = false>
__device__ __forceinline__ void gemm_phase(PG8_LAS unsigned char* lds, const Gemm g, const Sched& S, const Epi& E) {
    const int tid = threadIdx.x, wid = __builtin_amdgcn_readfirstlane(tid >> 6), lane = tid & 63, wr = wid >> 2, wc = wid & 3, fr = lane & 15, fq = lane >> 4;
    const int K = g.K, nt = K / BK;
    unsigned voffA[2], voffB[2];
#pragma unroll
    for (int i = 0; i < 2; ++i) { int R, C; stage_rc(tid * 16 + i * 8192, R, C); const int Rb = Epi::PERM ? ((R & ~31) + perm32(R & 31)) : R;
        voffA[i] = (unsigned)(R * K + C) * 2u; voffB[i] = (unsigned)(Rb * K + C) * 2u; }
    const size_t kstep = (size_t)(BK * 2);
    const size_t hstep = (size_t)HALF * K * 2;
    const size_t tstep = 2 * hstep;
    const unsigned ldsw = (unsigned)wid * 1024u;
    const int aoff = lds_byte(wr * 64 + fr, fq * 8), boff = lds_byte(wc * 32 + fr, fq * 8);
#define PG8_SA(b, h) (((b) * 2 + (h)) * HTB)
#define PG8_SB(b, h) ((4 + (b) * 2 + (h)) * HTB)
#define PG8_STAGE(bufoff, gbase, voff) do { _Pragma("unroll") for (int _i = 0; _i < 2; ++_i) \
        __builtin_amdgcn_global_load_lds((const unsigned*)((const char*)(gbase) + (voff)[_i]), (PG8_LAS unsigned*)(lds + (bufoff) + ldsw + _i * 8192), 16, 0, 0); } while (0)
#define PG8_LDA(dst, b, h) do { _Pragma("unroll") for (int m = 0; m < 4; ++m) _Pragma("unroll") for (int k = 0; k < 2; ++k) dst[m][k] = *(const PG8_LAS bf16x8*)(lds + PG8_SA(b, h) + aoff + m * 2048 + k * 1024); } while (0)
#define PG8_LDB(dst, b, h) do { _Pragma("unroll") for (int n = 0; n < 2; ++n) _Pragma("unroll") for (int k = 0; k < 2; ++k) dst[n][k] = *(const PG8_LAS bf16x8*)(lds + PG8_SB(b, h) + boff + n * 2048 + k * 1024); } while (0)
#define PG8_MMA(ai, bj, At, Bt) do { __builtin_amdgcn_s_setprio(1); _Pragma("unroll") for (int m = 0; m < 4; ++m) _Pragma("unroll") for (int n = 0; n < 2; ++n) _Pragma("unroll") for (int k = 0; k < 2; ++k) \
        acc[ai][bj][m][n] = __builtin_amdgcn_mfma_f32_16x16x32_bf16(Bt[n][k], At[m][k], acc[ai][bj][m][n], 0, 0, 0); __builtin_amdgcn_s_setprio(0); } while (0)
#define PG8_WAIT_V(n) asm volatile("s_waitcnt vmcnt(" #n ")" ::: "memory")
#define PG8_WAIT_L(n) asm volatile("s_waitcnt lgkmcnt(" #n ")" ::: "memory")
#define PG8_BAR __builtin_amdgcn_s_barrier()
#define PG8_SCHED __builtin_amdgcn_sched_barrier(0)
    Unit cur, nxt; int ui = 0;
    if (!S.next(0, cur)) return;
    f32x4 acc[2][2][4][2];
#pragma unroll
    for (int a = 0; a < 2; ++a)
#pragma unroll
        for (int b = 0; b < 2; ++b)
#pragma unroll
            for (int m = 0; m < 4; ++m)
#pragma unroll
                for (int n = 0; n < 2; ++n) acc[a][b][m][n] = (f32x4){0.f, 0.f, 0.f, 0.f};
    bf16x8 At[4][2], B0[2][2], B1[2][2];
    const char* cA = (const char*)g.A + (size_t)cur.pm * tstep; const char* cB = (const char*)g.Bt + (size_t)cur.pn * tstep;
    S.a_ready(cur);
    if constexpr (SP2) {
        PG8_STAGE(PG8_SB(0, 0), cB, voffB); PG8_STAGE(PG8_SB(0, 1), cB + hstep, voffB); PG8_STAGE(PG8_SA(0, 0), cA, voffA); PG8_STAGE(PG8_SA(0, 1), cA + hstep, voffA);
        if (wr == 1) PG8_BAR;
        PG8_WAIT_V(2); PG8_BAR;
        PG8_STAGE(PG8_SB(1, 0), cB + kstep, voffB); PG8_STAGE(PG8_SA(1, 0), cA + kstep, voffA); PG8_STAGE(PG8_SB(1, 1), cB + hstep + kstep, voffB);
        PG8_WAIT_V(6); PG8_BAR;
    } else {
        PG8_STAGE(PG8_SB(0, 0), cB, voffB); PG8_STAGE(PG8_SA(0, 0), cA, voffA); PG8_STAGE(PG8_SB(0, 1), cB + hstep, voffB); PG8_STAGE(PG8_SA(0, 1), cA + hstep, voffA);
        if (wr == 1) PG8_BAR;
        PG8_WAIT_V(4); PG8_BAR;
        PG8_STAGE(PG8_SB(1, 0), cB + kstep, voffB); PG8_STAGE(PG8_SA(1, 0), cA + kstep, voffA); PG8_STAGE(PG8_SB(1, 1), cB + hstep + kstep, voffB);
        PG8_WAIT_V(6); PG8_BAR;
    }
    for (;;) {
        const bool has_next = S.next(ui + 1, nxt);
        const char* nA = has_next ? (const char*)g.A + (size_t)nxt.pm * tstep : cA; const char* nB = has_next ? (const char*)g.Bt + (size_t)nxt.pn * tstep : cB;
        for (int t = 0; t < nt; t += 2) {
            if constexpr (Epi::HAS_MID) { if (t == Epi::MID_T) E.mid(acc, cur, wr, wc, fr, fq); }
            const bool last = (t == nt - 2);
            const char* a1 = cA + (size_t)(t + 1) * kstep;
            const char* a2 = last ? nA : cA + (size_t)(t + 2) * kstep; const char* b2 = last ? nB : cB + (size_t)(t + 2) * kstep;
            const char* a3 = a2 + kstep; const char* b3 = b2 + kstep;
            if (last && has_next) S.a_ready(nxt);
            if constexpr (SP2) {
            PG8_LDB(B0, 0, 0); PG8_LDB(B1, 0, 1); PG8_SCHED; PG8_LDA(At, 0, 0); PG8_STAGE(PG8_SA(1, 1), a1 + hstep, voffA);
            PG8_WAIT_V(8); PG8_WAIT_L(0); PG8_BAR; PG8_MMA(0, 0, At, B0); PG8_MMA(0, 1, At, B1); PG8_BAR; PG8_SCHED;
            PG8_LDA(At, 0, 1); PG8_STAGE(PG8_SB(0, 0), b2, voffB); PG8_STAGE(PG8_SB(0, 1), b2 + hstep, voffB); PG8_STAGE(PG8_SA(0, 0), a2, voffA);
            PG8_WAIT_V(8); PG8_WAIT_L(0); PG8_BAR; PG8_MMA(1, 0, At, B0); PG8_MMA(1, 1, At, B1); PG8_BAR; PG8_SCHED;
            PG8_LDB(B0, 1, 0); PG8_LDB(B1, 1, 1); PG8_SCHED; PG8_LDA(At, 1, 0); PG8_STAGE(PG8_SA(0, 1), a2 + hstep, voffA);
            PG8_WAIT_V(8); PG8_WAIT_L(0); PG8_BAR; PG8_MMA(0, 0, At, B0); PG8_MMA(0, 1, At, B1); PG8_BAR; PG8_SCHED;
            PG8_LDA(At, 1, 1); PG8_STAGE(PG8_SB(1, 0), b3, voffB); PG8_STAGE(PG8_SB(1, 1), b3 + hstep, voffB); PG8_STAGE(PG8_SA(1, 0), a3, voffA);
            PG8_WAIT_V(8); PG8_WAIT_L(0); PG8_BAR; PG8_MMA(1, 0, At, B0); PG8_MMA(1, 1, At, B1); PG8_BAR; PG8_SCHED;
            } else {
            PG8_LDB(B0, 0, 0); PG8_SCHED; PG8_LDA(At, 0, 0); PG8_STAGE(PG8_SA(1, 1), a1 + hstep, voffA);
            PG8_WAIT_L(8); PG8_BAR; PG8_WAIT_L(0); PG8_MMA(0, 0, At, B0); PG8_BAR; PG8_SCHED;
            PG8_LDB(B1, 0, 1); PG8_STAGE(PG8_SB(0, 0), b2, voffB);
            PG8_BAR; PG8_WAIT_L(0); PG8_MMA(0, 1, At, B1); PG8_BAR;
            PG8_LDA(At, 0, 1); PG8_STAGE(PG8_SA(0, 0), a2, voffA);
            PG8_BAR; PG8_WAIT_L(0); PG8_MMA(1, 0, At, B0); PG8_BAR; PG8_SCHED;
            PG8_STAGE(PG8_SB(0, 1), b2 + hstep, voffB);
            PG8_WAIT_V(6); PG8_BAR; PG8_MMA(1, 1, At, B1); PG8_BAR;
            PG8_LDB(B0, 1, 0); PG8_SCHED; PG8_LDA(At, 1, 0); PG8_STAGE(PG8_SA(0, 1), a2 + hstep, voffA);
            PG8_WAIT_L(8); PG8_BAR; PG8_WAIT_L(0); PG8_MMA(0, 0, At, B0); PG8_BAR; PG8_SCHED;
            PG8_LDB(B1, 1, 1); PG8_STAGE(PG8_SB(1, 0), b3, voffB);
            PG8_BAR; PG8_WAIT_L(0); PG8_MMA(0, 1, At, B1); PG8_BAR;
            PG8_LDA(At, 1, 1); PG8_STAGE(PG8_SA(1, 0), a3, voffA);
            PG8_BAR; PG8_WAIT_L(0); PG8_MMA(1, 0, At, B0); PG8_BAR; PG8_SCHED;
            PG8_STAGE(PG8_SB(1, 1), b3 + hstep, voffB);
            PG8_WAIT_V(6); PG8_BAR; PG8_MMA(1, 1, At, B1); PG8_BAR;
            }
        }
        if constexpr (ALIGN_EPI) { if (wr == 0) PG8_BAR; }
        if constexpr (!Epi::AFTER_DRAIN) { E(acc, cur, wr, wc, fr, fq); S.done(cur); }
        if (!has_next) break;
#pragma unroll
        for (int a = 0; a < 2; ++a)
#pragma unroll
            for (int b = 0; b < 2; ++b)
#pragma unroll
                for (int m = 0; m < 4; ++m)
#pragma unroll
                    for (int n = 0; n < 2; ++n) acc[a][b][m][n] = (f32x4){0.f, 0.f, 0.f, 0.f};
        cur = nxt; cA = nA; cB = nB; ++ui;
        if constexpr (ALIGN_EPI) { if (wr == 1) PG8_BAR; }
    }
    PG8_WAIT_V(0);
    if constexpr (!ALIGN_EPI) { if (wr == 0) PG8_BAR; }
    PG8_BAR;
#undef PG8_SA
#undef PG8_SB
#undef PG8_STAGE
#undef PG8_LDA
#undef PG8_LDB
#undef PG8_MMA
#undef PG8_WAIT_V
#undef PG8_WAIT_L
#undef PG8_BAR
#undef PG8_SCHED
}
template <class Epi>
__device__ __forceinline__ void gemm_tail(PG8_LAS unsigned char* lds, const Gemm g, const StaticOrder& S, const Epi& E) {
    int tid_ = threadIdx.x; asm volatile("" : "+v"(tid_));
    const int tid = tid_, wid = __builtin_amdgcn_readfirstlane(tid >> 6), lane = tid & 63, fr = lane & 15, fq = lane >> 4, wm = wid >> 1, wn = wid & 1;
    const int K = g.K, nt = K / 64, nleft = S.nwg - S.limit;
    constexpr int SLOT = 16384, NS = 8;
    for (int st = S.c; st < nleft * 16; st += S.G) {
        Unit u; S.unit_of(S.limit + (st >> 4), u); const int sub = st & 15;
        const int row0 = u.pm * BM + (sub >> 2) * 64, col0 = u.pn * BM + (sub & 3) * 64;
        const int pr = 8 * wid + (lane >> 3), pc = (lane & 7) ^ (pr & 7);
        const char* srcA = (const char*)(g.A + (size_t)(row0 + pr) * K) + pc * 16;
        const char* srcB = (const char*)(g.Bt + (size_t)(col0 + pr) * K) + pc * 16;
        const unsigned dA = (unsigned)wid * 1024u, dB = 8192u + (unsigned)wid * 1024u;
#define PG8_TSTAGE(kt) do { PG8_LAS unsigned char* sl_ = lds + ((kt) & (NS - 1)) * SLOT; \
            __builtin_amdgcn_global_load_lds((const unsigned*)(srcA + (size_t)(kt) * 128), (PG8_LAS unsigned*)(sl_ + dA), 16, 0, 0); \
            __builtin_amdgcn_global_load_lds((const unsigned*)(srcB + (size_t)(kt) * 128), (PG8_LAS unsigned*)(sl_ + dB), 16, 0, 0); } while (0)
        f32x4 acc[2];
        acc[0] = (f32x4){0.f, 0.f, 0.f, 0.f}; acc[1] = (f32x4){0.f, 0.f, 0.f, 0.f};
        const int ra = 16 * wm + fr, rb0 = 32 * wn + fr, rb1 = rb0 + 16;
#pragma unroll
        for (int kt = 0; kt < NS - 1; ++kt) PG8_TSTAGE(kt);
        for (int kt = 0; kt < nt; ++kt) {
            if (Epi::HAS_MID && kt == Epi::MID_T) E.tail_mid(acc, row0 + ra, col0 + 32 * wn + 4 * fq);
            const int newer = nt - 1 - kt;
            if (newer >= 6) asm volatile("s_waitcnt vmcnt(12)" ::: "memory");
            else if (newer == 5) asm volatile("s_waitcnt vmcnt(10)" ::: "memory");
            else if (newer == 4) asm volatile("s_waitcnt vmcnt(8)" ::: "memory");
            else if (newer == 3) asm volatile("s_waitcnt vmcnt(6)" ::: "memory");
            else if (newer == 2) asm volatile("s_waitcnt vmcnt(4)" ::: "memory");
            else if (newer == 1) asm volatile("s_waitcnt vmcnt(2)" ::: "memory");
            else asm volatile("s_waitcnt vmcnt(0)" ::: "memory");
            __builtin_amdgcn_s_barrier();
            if (kt + NS - 1 < nt) PG8_TSTAGE(kt + NS - 1);
            const PG8_LAS unsigned char* sl = lds + (kt & (NS - 1)) * SLOT;
            bf16x8 a[2], b0[2], b1[2];
#pragma unroll
            for (int h = 0; h < 2; ++h) { const int c = 4 * h + fq;
                a[h] = *(const PG8_LAS bf16x8*)(sl + ra * 128 + ((c ^ (ra & 7)) * 16));
                b0[h] = *(const PG8_LAS bf16x8*)(sl + 8192 + rb0 * 128 + ((c ^ (rb0 & 7)) * 16));
                b1[h] = *(const PG8_LAS bf16x8*)(sl + 8192 + rb1 * 128 + ((c ^ (rb1 & 7)) * 16)); }
#pragma unroll
            for (int h = 0; h < 2; ++h) { acc[0] = __builtin_amdgcn_mfma_f32_16x16x32_bf16(b0[h], a[h], acc[0], 0, 0, 0); acc[1] = __builtin_amdgcn_mfma_f32_16x16x32_bf16(b1[h], a[h], acc[1], 0, 0, 0); }
        }
        E.tail_out(acc, row0 + ra, col0 + 32 * wn + 4 * fq);
        asm volatile("s_waitcnt lgkmcnt(0)" ::: "memory"); __builtin_amdgcn_s_barrier();
#undef PG8_TSTAGE
    }
}
}

#define XB_TMO      128
#define XB_XCNT(j)  (256  + 64 * (j))
#define XB_XSUB(j)  (1280 + 64 * (j))
#define XB_XGEN(j)  (2304 + 64 * (j))
#define XB_TOP      3328
#define XB_TOPGEN   3392
#define XCD_BAR_WORDS 3456
#define XB_SPIN_CAP (1u << 18)
__device__ __forceinline__ unsigned xb_ld(unsigned* p)              { return __hip_atomic_load(p, __ATOMIC_RELAXED, __HIP_MEMORY_SCOPE_AGENT); }
__device__ __forceinline__ unsigned xb_add(unsigned* p, unsigned v) { return __hip_atomic_fetch_add(p, v, __ATOMIC_RELAXED, __HIP_MEMORY_SCOPE_AGENT); }
__device__ __forceinline__ unsigned xb_xcc_id() { return (unsigned)__builtin_amdgcn_s_getreg((3 << 11) | 20) & 0xFu; }
#define XB_SPIN(cond, bar) do { unsigned _sp = 0; while (cond) { __builtin_amdgcn_s_sleep(1); \
    if ((++_sp & 255u) == 0u) { if (xb_ld(&(bar)[XB_TMO])) break; if (_sp > XB_SPIN_CAP) { atomicAdd(&(bar)[XB_TMO], 1u); break; } } } } while (0)
struct XcdBarrier { unsigned* bar; unsigned x; volatile LAS unsigned* st; };
__device__ __forceinline__ XcdBarrier xcd_barrier_post(unsigned* bar, volatile LAS unsigned* st) {
    XcdBarrier b; b.bar = bar; b.x = xb_xcc_id(); b.st = st;
    if (threadIdx.x == 0) (void)xb_add(&bar[XB_XCNT(b.x)], 1u);
    return b;
}
__device__ __forceinline__ void xcd_barrier_complete(unsigned* bar, unsigned x, unsigned& nloc, unsigned& nx) {
    const unsigned G = gridDim.x * gridDim.y * gridDim.z;
    unsigned sum, cnt, mine, sp = 0u;
    for (;;) {
        sum = 0u; cnt = 0u; mine = 0u;
#pragma unroll
        for (unsigned j = 0; j < 16; ++j) { const unsigned c = xb_ld(&bar[XB_XCNT(j)]); sum += c; cnt += (c > 0u) ? 1u : 0u; mine = (j == x) ? c : mine; }
        if (sum == G) break;
        __builtin_amdgcn_s_sleep(1);
        if ((++sp & 255u) == 0u) { if (xb_ld(&bar[XB_TMO])) break; if (sp > XB_SPIN_CAP) { atomicAdd(&bar[XB_TMO], 1u); break; } }
    }
    nloc = mine > 0u ? mine : 1u; nx = cnt > 0u ? cnt : 1u;
}
__device__ __forceinline__ void xcd_barrier(const XcdBarrier& b) {
    asm volatile("s_waitcnt vmcnt(0)" ::: "memory");
    __syncthreads();
    if (threadIdx.x == 0) {
        unsigned* bar = b.bar;
        __builtin_amdgcn_s_waitcnt(0);
        unsigned nloc = b.st[0], nx = b.st[1];
        if (nloc == 0u) { xcd_barrier_complete(bar, b.x, nloc, nx); b.st[0] = nloc; b.st[1] = nx; }
        const unsigned old = xb_add(&bar[XB_XSUB(b.x)], 1u);
        const unsigned gen = old / nloc;
        if (old + 1u == (gen + 1u) * nloc) {
            __builtin_amdgcn_fence(__ATOMIC_RELEASE, "agent");
            asm volatile("s_waitcnt vmcnt(0)" ::: "memory");
            const unsigned og = xb_add(&bar[XB_TOP], 1u);
            const unsigned tg = og / nx;
            if (og + 1u == (tg + 1u) * nx) xb_add(&bar[XB_TOPGEN], 1u);
            else XB_SPIN(xb_ld(&bar[XB_TOPGEN]) == tg, bar);
            __builtin_amdgcn_fence(__ATOMIC_ACQUIRE, "agent");
            xb_add(&bar[XB_XGEN(b.x)], 1u);
            asm volatile("s_waitcnt vmcnt(0)" ::: "memory");
        } else {
            XB_SPIN(xb_ld(&bar[XB_XGEN(b.x)]) == gen, bar);
            __builtin_amdgcn_fence(__ATOMIC_ACQUIRE, "agent");
            asm volatile("s_waitcnt vmcnt(0)" ::: "memory");
        }
    }
    __syncthreads();
}

struct Frame {
    LAS unsigned char* lds;
    volatile LAS unsigned* MISC;
    gu32* ctl;
    int tid, lane, wave, vcu, G, mode;
    const float *xp, *xs, *ck, *cv, *sconv, *npre, *npost, *w_in, *lq1, *lk1, *lq2, *lk2, *hnorm, *convw, *wpa, *wpc, *wout, *relb;
    float* out;
    unsigned char* ws;
    __device__ __forceinline__ bf16_t* W1T() const { return (bf16_t*)(ws + WS_W1T); }
    __device__ __forceinline__ bf16_t* W3T() const { return (bf16_t*)(ws + WS_W3T); }
    __device__ __forceinline__ bf16_t* W4T() const { return (bf16_t*)(ws + WS_W4T); }
    __device__ __forceinline__ bf16_t* XN() const { return (bf16_t*)(ws + WS_XN); }
    __device__ __forceinline__ bf16_t* QB() const { return (bf16_t*)(ws + WS_QB); }
    __device__ __forceinline__ bf16_t* KB() const { return (bf16_t*)(ws + WS_KB); }
    __device__ __forceinline__ bf16_t* VB() const { return (bf16_t*)(ws + WS_VB); }
    __device__ __forceinline__ bf16_t* A3() const { return (bf16_t*)(ws + WS_A3); }
    __device__ __forceinline__ bf16_t* U() const { return (bf16_t*)(ws + WS_U); }
    __device__ __forceinline__ bf16_t* RB() const { return (bf16_t*)(ws + WS_RB); }
    __device__ __forceinline__ bf16_t* S2() const { return (bf16_t*)(ws + WS_S2); }
    __device__ __forceinline__ bf16_t* MB() const { return (bf16_t*)(ws + WS_MB); }
    __device__ __forceinline__ bf16_t* Y() const { return (bf16_t*)(ws + WS_Y); }
};
__device__ __forceinline__ float wave_sum(float v) {
#pragma unroll
    for (int o = 1; o < 64; o <<= 1) v += __shfl_xor(v, o);
    return v;
}

template <class ColMap>
__device__ __forceinline__ void p0_tr_item(const float* W, int ldw, bf16_t* WT, int ldt, int koff, int k0, int n0, const ColMap& cm, LAS float* scr, int lane) {
    const int sc = cm(n0 + (lane & 31));
#pragma unroll 8
    for (int i = 0; i < 32; ++i) { const int kk = 2 * i + (lane >> 5); scr[kk * 33 + (lane & 31)] = W[(size_t)(k0 + kk) * ldw + sc]; }
    LDS_WAIT(); asm volatile("" ::: "memory");
    const int c = lane & 7;
#pragma unroll
    for (int j = 0; j < 4; ++j) { const int n = (lane >> 3) + 8 * j; const LAS float* s = scr + (8 * c) * 33 + n;
        u32x4 o; o.x = pk_bf16(s[0 * 33], s[1 * 33]); o.y = pk_bf16(s[2 * 33], s[3 * 33]); o.z = pk_bf16(s[4 * 33], s[5 * 33]); o.w = pk_bf16(s[6 * 33], s[7 * 33]);
        *(GAS u32x4*)(WT + (size_t)(n0 + n) * ldt + koff + k0 + 8 * c) = o; }
    LDS_WAIT(); asm volatile("" ::: "memory");
}
struct CmId { __device__ __forceinline__ int operator()(int n) const { return n; } };
struct CmW1 { __device__ __forceinline__ int operator()(int n) const { return orig_col(n); } };
__device__ __forceinline__ void rms_row_to_bf16(const float* xrow, const float* g, bf16_t* orow, int lane) {
    const GAS f32x4* xr = (const GAS f32x4*)xrow + lane; const GAS f32x4* gr = (const GAS f32x4*)g + lane;
    f32x4 v[8]; float s = 0.f;
#pragma unroll
    for (int j = 0; j < 8; ++j) { v[j] = xr[64 * j]; s += (v[j].x * v[j].x + v[j].y * v[j].y) + (v[j].z * v[j].z + v[j].w * v[j].w); }
    const float rs = 1.f / sqrtf(wave_sum(s) * (1.f / D_MODEL) + EPS);
    GAS u32x2* o8 = (GAS u32x2*)orow + lane;
#pragma unroll
    for (int j = 0; j < 8; ++j) { const f32x4 gg = gr[64 * j]; u32x2 w; w.x = pk_bf16(v[j].x * rs * gg.x, v[j].y * rs * gg.y); w.y = pk_bf16(v[j].z * rs * gg.z, v[j].w * rs * gg.w); o8[64 * j] = w; }
}
__device__ __forceinline__ void p0_prologue(Frame& F) {
    LAS float* scr = (LAS float*)(F.lds + F.wave * 16384);
    const int gw = F.vcu * NWAVES + F.wave, NGW = F.G * NWAVES;
    constexpr int I_1 = (D_MODEL / 64) * (N_IN / 32), I_3 = (1024 / 64) * (D_MODEL / 32), I_4 = (D_MODEL / 64) * (D_MODEL / 32);
    constexpr int NITEMS = I_1 + 2 * I_3 + I_4;
    for (int it = gw; it < NITEMS; it += NGW) {
        int r = it;
        if (r < I_1) { const int nblk = N_IN / 32, kb = r / nblk, nb = r % nblk; p0_tr_item(F.w_in, N_IN, F.W1T(), D_MODEL, 0, 64 * kb, 32 * nb, CmW1{}, scr, F.lane); continue; } r -= I_1;
        if (r < I_3) { const int nblk = D_MODEL / 32, kb = r / nblk, nb = r % nblk; p0_tr_item(F.wpa, D_MODEL, F.W3T(), 2048, 0, 64 * kb, 32 * nb, CmId{}, scr, F.lane); continue; } r -= I_3;
        if (r < I_3) { const int nblk = D_MODEL / 32, kb = r / nblk, nb = r % nblk; p0_tr_item(F.wpc, D_MODEL, F.W3T(), 2048, 1024, 64 * kb, 32 * nb, CmId{}, scr, F.lane); continue; } r -= I_3;
        { const int nblk = D_MODEL / 32, kb = r / nblk, nb = r % nblk; p0_tr_item(F.wout, D_MODEL, F.W4T(), 2048, 0, 64 * kb, 32 * nb, CmId{}, scr, F.lane); }
    }
    for (int m = gw; m < M; m += NGW) { const float* xr = (m < MP) ? F.xp + (size_t)m * D_MODEL : F.xs + (size_t)(m - MP) * D_MODEL; rms_row_to_bf16(xr, F.npre, F.XN() + (size_t)m * D_MODEL, F.lane); }
}

namespace att {
constexpr int L_K = 0, L_V = 32768, L_STG = 65536, TILEB = 16384;
constexpr float THR = 8.f;
__device__ __forceinline__ int off_b(int row, int ch) { return 256 * row + 16 * (ch ^ (((row & 3) << 2) | ((row >> 2) & 3))); }
__device__ __forceinline__ int crow(int r, int hi) { return (r & 3) + 8 * (r >> 2) + 4 * hi; }
typedef short v4i16_t __attribute__((ext_vector_type(4)));
__device__ __forceinline__ s16x4 vtr(LAS const unsigned char* p) { return __builtin_bit_cast(s16x4, __builtin_amdgcn_ds_read_tr16_b64_v4i16((LAS v4i16_t*)p)); }
#define MFMA32(a, b, c) __builtin_amdgcn_mfma_f32_32x32x16_bf16((a), (b), (c), 0, 0, 0)
__device__ __forceinline__ int rel_bucket(int rel) {
    const int ret = rel > 0 ? 16 : 0, n = rel < 0 ? -rel : rel;
    if (n < 8) return ret + n;
    int large = 8 + (31 - __clz(n * n)) - 6; large = large > 15 ? 15 : large;
    return ret + large;
}
__device__ __forceinline__ void qk_map(f32x16& p0, f32x16& p1, LAS const unsigned char* kbuf, LAS const unsigned char* qbuf, int map, const f32x16& cinit, int r32, int hi) {
    const int xr = ((r32 & 3) << 2) | ((r32 >> 2) & 3), rb = 256 * r32;
#pragma unroll
    for (int s = 0; s < 4; ++s) {
        const int o = rb + 16 * ((map * 8 + 2 * s + hi) ^ xr);
        const bf16x8 qf = *(LAS const bf16x8*)(qbuf + o);
        const bf16x8 a0 = *(LAS const bf16x8*)(kbuf + o), a1 = *(LAS const bf16x8*)(kbuf + o + 8192);
        if (s == 0) { p0 = MFMA32(a0, qf, cinit); p1 = MFMA32(a1, qf, cinit); } else { p0 = MFMA32(a0, qf, p0); p1 = MFMA32(a1, qf, p1); }
    }
}
__device__ __forceinline__ float rowmax32(const f32x16& p0, const f32x16& p1) {
    float a = __builtin_fmaxf(p0[0], p1[0]);
#pragma unroll
    for (int r = 1; r < 16; ++r) a = __builtin_fmaxf(__builtin_fmaxf(a, p0[r]), p1[r]);
    return __builtin_fmaxf(a, __shfl_xor(a, 32));
}
template <int NB, bool PIPE = false>
__device__ __forceinline__ void softmax_tile(f32x16& p0, f32x16& p1, float& m, float& l, f32x16 (&o)[NB], f32x16& negm, float c15, bool first, f32x16* pn0 = nullptr, f32x16* pn1 = nullptr) {
    if (first) { const float rm = rowmax32(p0, p1); m = rm;
#pragma unroll
        for (int r = 0; r < 16; ++r) { p0[r] -= rm; p1[r] -= rm; negm[r] = c15 - rm; if (PIPE) { (*pn0)[r] -= rm; (*pn1)[r] -= rm; } } }
    f32x16 e0, e1; float s = 0.f;
#pragma unroll
    for (int r = 0; r < 16; ++r) { e0[r] = fast_exp2(p0[r]); e1[r] = fast_exp2(p1[r]); s += e0[r] + e1[r]; }
    if (__builtin_expect(__any(!(s <= 4096.f)), 0)) {
        const float rm = rowmax32(p0, p1), dl = fmaxf(rm, 0.f); m += dl;
        const float f = fast_exp2(-dl); l *= f; s = 0.f;
#pragma unroll
        for (int r = 0; r < 16; ++r) { e0[r] = fast_exp2(p0[r] - dl); e1[r] = fast_exp2(p1[r] - dl); s += e0[r] + e1[r]; negm[r] = c15 - m; if (PIPE) { (*pn0)[r] -= dl; (*pn1)[r] -= dl; } }
#pragma unroll
        for (int i = 0; i < NB; ++i)
#pragma unroll
            for (int r = 0; r < 16; ++r) o[i][r] *= f;
    }
    l += s; p0 = e0; p1 = e1;
}
__device__ __forceinline__ bf16x8 pack8(const f32x16& p, int s) {
    u32x4 w; w.x = pk_bf16(p[8 * s], p[8 * s + 1]); w.y = pk_bf16(p[8 * s + 2], p[8 * s + 3]); w.z = pk_bf16(p[8 * s + 4], p[8 * s + 5]); w.w = pk_bf16(p[8 * s + 6], p[8 * s + 7]);
    return __builtin_bit_cast(bf16x8, w);
}
__device__ __forceinline__ void add_bias(f32x16& p0, f32x16& p1, LAS const float* tab, int idx0) {
#pragma unroll
    for (int r = 0; r < 16; ++r) { const int o = idx0 + (r & 3) + 8 * (r >> 2); p0[r] += tab[o]; p1[r] += tab[o + 32]; }
}
__device__ __forceinline__ bf16x8 vfrag(LAS const unsigned char* vbuf, int c, int half, int s, int lane) {
    const int hi = lane >> 5, blk = (lane >> 4) & 1, qp = (lane & 15) >> 2, p = lane & 3;
    const int lo = 256 * qp + 8 * (p & 1) + 16 * (4 * (c ^ qp));
    const int R0 = 32 * half + 16 * s + 4 * hi;
    const int a0 = lo + 256 * R0 + 16 * ((2 * blk + (p >> 1)) ^ hi), a1 = lo + 256 * (R0 + 8) + 16 * ((2 * blk + (p >> 1)) ^ (2 + hi));
    const s16x4 x = vtr(vbuf + a0), y = vtr(vbuf + a1);
    return (bf16x8){x[0], x[1], x[2], x[3], y[0], y[1], y[2], y[3]};
}
struct TileRegs { u32x4 k0, k1, v0, v1; };
__device__ __forceinline__ void load_tile_bf16(TileRegs& R, const bf16_t* Kb, const bf16_t* Vb, size_t row0, int h, int tid, int nvalid) {
    const int row = tid >> 3, c = tid & 7;
    if (row < nvalid) { const u32x4* kp = (const u32x4*)(Kb + (row0 + row) * 1024 + h * 128); const u32x4* vp = (const u32x4*)(Vb + (row0 + row) * 1024 + h * 128);
        R.k0 = kp[c]; R.k1 = kp[c + 8]; R.v0 = vp[c]; R.v1 = vp[c + 8]; }
    else { R.k0 = R.k1 = R.v0 = R.v1 = (u32x4){0u, 0u, 0u, 0u}; }
}
__device__ __forceinline__ void store_tile_bf16(const TileRegs& R, LAS unsigned char* kbuf, LAS unsigned char* vbuf, int tid) {
    const int row = tid >> 3, c = tid & 7;
    *(LAS u32x4*)(kbuf + off_b(row, c)) = R.k0; *(LAS u32x4*)(kbuf + off_b(row, c + 8)) = R.k1;
    *(LAS u32x4*)(vbuf + off_b(row, c)) = R.v0; *(LAS u32x4*)(vbuf + off_b(row, c + 8)) = R.v1;
}
__device__ __forceinline__ void load_half_bf16(u32x4& r0, u32x4& r1, const bf16_t* B, size_t row0, int h, int tid) { const int row = tid >> 3, c = tid & 7; const u32x4* p = (const u32x4*)(B + (row0 + row) * 1024 + h * 128); r0 = p[c]; r1 = p[c + 8]; }
__device__ __forceinline__ void store_half_bf16(const u32x4& r0, const u32x4& r1, LAS unsigned char* buf, int tid) { const int row = tid >> 3, c = tid & 7; *(LAS u32x4*)(buf + off_b(row, c)) = r0; *(LAS u32x4*)(buf + off_b(row, c + 8)) = r1; }
struct TileRegsF { f32x4 k[4], v[4]; };
__device__ __forceinline__ void load_tile_f32(TileRegsF& R, const float* ck, const float* cv, int key0, int h, int tid) {
    const int pc = tid & 31;
#pragma unroll
    for (int i = 0; i < 4; ++i) { const int row = (tid >> 5) + 16 * i; const size_t o = ((size_t)(key0 + row) * NH + h) * 128 + pc * 4;
        R.k[i] = __builtin_nontemporal_load((const f32x4*)(ck + o)); R.v[i] = __builtin_nontemporal_load((const f32x4*)(cv + o)); }
}
__device__ __forceinline__ void store_tile_f32(const TileRegsF& R, LAS unsigned char* kbuf, LAS unsigned char* vbuf, int tid) {
    const int pc = tid & 31;
#pragma unroll
    for (int i = 0; i < 4; ++i) { const int row = (tid >> 5) + 16 * i; const int o = off_b(row, pc >> 1) + 8 * (pc & 1);
        u32x2 a; a.x = pk_bf16(R.k[i].x, R.k[i].y); a.y = pk_bf16(R.k[i].z, R.k[i].w); *(LAS u32x2*)(kbuf + o) = a;
        u32x2 b; b.x = pk_bf16(R.v[i].x, R.v[i].y); b.y = pk_bf16(R.v[i].z, R.v[i].w); *(LAS u32x2*)(vbuf + o) = b; }
}
__device__ __forceinline__ void stage_q(LAS unsigned char* qbuf, const bf16_t* Qb, size_t row0, int nrows, int h, int lane) {
#pragma unroll
    for (int i = 0; i < 8; ++i) { const int row = (lane >> 4) + 4 * i, ch = lane & 15; const int rr = row < nrows ? row : row % nrows;
        *(LAS u32x4*)(qbuf + off_b(row, ch)) = *(const u32x4*)(Qb + (row0 + rr) * 1024 + h * 128 + ch * 8); }
}

__device__ __forceinline__ void prompt_unit(Frame& F, int b, int h, int qb, float lam) {
    int tid_ = F.tid; asm volatile("" : "+v"(tid_));
    const int tid = tid_, lane = tid_ & 63, wid = F.wave, map = wid >> 2, qblk = wid & 3;
    LAS unsigned char* lds = F.lds; LAS float* tab = (LAS float*)(lds + TAB_OFF); LAS const float* hn = (LAS const float*)(lds + HN_OFF);
    LAS unsigned char* qbuf = lds + L_STG + wid * 8192;
    const float c15 = F.relb[15 * NH + h] * LOG2E;
    if (tid < 256) tab[tid] = F.relb[rel_bucket(tid - 192) * NH + h] * LOG2E - c15;
    const int q0w = 128 * qb + 32 * qblk, cw = 2 * qb + (qblk >> 1), NT = 2 * qb + 2;
    const size_t rowb = (size_t)b * SEQ;
    stage_q(qbuf, F.QB(), rowb + q0w, 32, h, lane);
    TileRegs R;
    load_half_bf16(R.k0, R.k1, F.KB(), rowb, h, tid); load_half_bf16(R.v0, R.v1, F.VB(), rowb, h, tid);
    store_half_bf16(R.k0, R.k1, lds + L_K, tid); store_half_bf16(R.v0, R.v1, lds + L_V, tid);
    load_half_bf16(R.k0, R.k1, F.KB(), rowb + 64, h, tid); store_half_bf16(R.k0, R.k1, lds + L_K + TILEB, tid);
    __syncthreads();
    float m = 0.f, l = 0.f; f32x16 o[4], negm;
#pragma unroll
    for (int c = 0; c < 4; ++c)
#pragma unroll
        for (int r = 0; r < 16; ++r) o[c][r] = 0.f;
#pragma unroll
    for (int r = 0; r < 16; ++r) negm[r] = c15;
    const int r32 = lane & 31, hi = lane >> 5;
    f32x16 pa0, pa1, pb0, pb1;
    qk_map(pa0, pa1, lds + L_K, qbuf, map, negm, r32, hi);
    if (-q0w > -154) add_bias(pa0, pa1, tab, -(q0w + r32) + 192 + 4 * hi);
    { const float rm = rowmax32(pa0, pa1); m = rm;
#pragma unroll
      for (int r = 0; r < 16; ++r) { pa0[r] -= rm; pa1[r] -= rm; negm[r] = c15 - rm; } }
#define PROMPT_STEP(t, P0, P1, N0, N1) do { \
        int tidl = tid; asm volatile("" : "+v"(tidl)); const int lanel = tidl & 63; \
        if ((t) + 2 < NT) load_half_bf16(R.k0, R.k1, F.KB(), rowb + (size_t)((t) + 2) * 64, h, tidl); \
        if ((t) + 1 < NT) load_half_bf16(R.v0, R.v1, F.VB(), rowb + (size_t)((t) + 1) * 64, h, tidl); \
        if ((t) <= cw) { \
            LAS const unsigned char* vbuf = lds + L_V + ((t) & 1) * TILEB; \
            qk_map(N0, N1, lds + L_K + (((t) + 1) & 1) * TILEB, qbuf, map, negm, r32, hi);        \
            float s_ = 0.f; \
            _Pragma("unroll") for (int r = 0; r < 16; ++r) { P0[r] = fast_exp2(P0[r]); P1[r] = fast_exp2(P1[r]); } \
            _Pragma("unroll") for (int r = 0; r < 16; ++r) s_ += P0[r] + P1[r]; \
            __builtin_amdgcn_sched_group_barrier(0x100, 12, 0); \
            _Pragma("unroll") for (int i_ = 0; i_ < 8; ++i_) { __builtin_amdgcn_sched_group_barrier(0x8, 1, 0); __builtin_amdgcn_sched_group_barrier(0x400, 4, 0); } \
            if (__builtin_expect(__any(!(s_ <= 4096.f)), 0)) {          \
                qk_map(P0, P1, lds + L_K + ((t) & 1) * TILEB, qbuf, map, negm, r32, hi);          \
                if (64 * (t) - q0w > -154) add_bias(P0, P1, tab, 64 * (t) - (q0w + r32) + 192 + 4 * hi); \
                const float rm = rowmax32(P0, P1), dl = fmaxf(rm, 0.f); m += dl; \
                const float f = fast_exp2(-dl); l *= f; s_ = 0.f; \
                _Pragma("unroll") for (int r = 0; r < 16; ++r) { P0[r] = fast_exp2(P0[r] - dl); P1[r] = fast_exp2(P1[r] - dl); s_ += P0[r] + P1[r]; negm[r] = c15 - m; N0[r] -= dl; N1[r] -= dl; } \
                _Pragma("unroll") for (int c = 0; c < 4; ++c) _Pragma("unroll") for (int r = 0; r < 16; ++r) o[c][r] *= f; \
            } \
            l += s_; \
            if (64 * ((t) + 1) - q0w > -154) add_bias(N0, N1, tab, 64 * ((t) + 1) - (q0w + r32) + 192 + 4 * hi); \
            bf16x8 pf[2][2]; pf[0][0] = pack8(P0, 0); pf[0][1] = pack8(P0, 1); pf[1][0] = pack8(P1, 0); pf[1][1] = pack8(P1, 1); \
            _Pragma("unroll") for (int c = 0; c < 4; ++c) _Pragma("unroll") for (int half = 0; half < 2; ++half) _Pragma("unroll") for (int s = 0; s < 2; ++s) \
                o[c] = MFMA32(vfrag(vbuf, c, half, s, lanel), pf[half][s], o[c]); \
        } \
        if ((t) + 2 < NT) store_half_bf16(R.k0, R.k1, lds + L_K + ((t) & 1) * TILEB, tidl); \
        if ((t) + 1 < NT) store_half_bf16(R.v0, R.v1, lds + L_V + (((t) + 1) & 1) * TILEB, tidl); \
        __syncthreads(); } while (0)
    for (int t = 0; t < NT; t += 2) {
        PROMPT_STEP(t, pa0, pa1, pb0, pb1);
        PROMPT_STEP(t + 1, pb0, pb1, pa0, pa1);
    }
#undef PROMPT_STEP
    int lane2 = lane; asm volatile("" : "+v"(lane2));
    const int r32e = lane2 & 31, hie = lane2 >> 5;
    l += __shfl_xor(l, 32);
    LAS float* xch = (LAS float*)(lds + L_STG + qblk * 16384);
    if (map == 1) { const float i2 = lam / l;
#pragma unroll
        for (int c = 0; c < 4; ++c)
#pragma unroll
            for (int r = 0; r < 16; ++r) xch[(c * 16 + r) * 64 + lane2] = o[c][r] * i2; }
    __syncthreads();
    if (map == 0) {
        const float i1 = 1.f / l; float ssq = 0.f;
#pragma unroll
        for (int c = 0; c < 4; ++c)
#pragma unroll
            for (int r = 0; r < 16; ++r) { const float v = o[c][r] * i1 - xch[(c * 16 + r) * 64 + lane2]; o[c][r] = v; ssq += v * v; }
        ssq += __shfl_xor(ssq, 32);
        const float rs = 1.f / sqrtf(ssq * (1.f / DV) + EPS);
        LAS unsigned char* ob = (LAS unsigned char*)xch;
#pragma unroll
        for (int c = 0; c < 4; ++c)
#pragma unroll
            for (int g = 0; g < 4; ++g) { const int d = 32 * c + 8 * g + 4 * hie; const f32x4 hv = *(LAS const f32x4*)(hn + d);
                u32x2 w; w.x = pk_bf16(o[c][4 * g] * rs * hv.x, o[c][4 * g + 1] * rs * hv.y); w.y = pk_bf16(o[c][4 * g + 2] * rs * hv.z, o[c][4 * g + 3] * rs * hv.w);
                *(LAS u32x2*)(ob + r32e * 256 + (((4 * c + g) ^ (r32e & 7)) * 16) + hie * 8) = w; }
#pragma unroll
        for (int i = 0; i < 8; ++i) { const int row = 4 * i + (lane2 >> 4), c16 = lane2 & 15;
            const u32x4 v = *(LAS const u32x4*)(ob + row * 256 + ((c16 ^ (row & 7)) * 16));
            bf16_t* ap = F.A3() + (rowb + q0w + row) * 2048 + h * 128 + c16 * 8; const u32x4 z = *(const u32x4*)ap;
            u32x4 w; w.x = pk_bf16(bf_lo(v.x) * bf_lo(z.x), bf_hi(v.x) * bf_hi(z.x)); w.y = pk_bf16(bf_lo(v.y) * bf_lo(z.y), bf_hi(v.y) * bf_hi(z.y));
            w.z = pk_bf16(bf_lo(v.z) * bf_lo(z.z), bf_hi(v.z) * bf_hi(z.z)); w.w = pk_bf16(bf_lo(v.w) * bf_lo(z.w), bf_hi(v.w) * bf_hi(z.w));
            *(u32x4*)ap = w; }
    }
    __syncthreads();
}

__device__ __forceinline__ void sample_unit(Frame& F, int b, int h, float lam, int tb, int te) {
    int tid_ = F.tid; asm volatile("" : "+v"(tid_));
    const int tid = tid_, lane = tid_ & 63, wid = F.wave, r32 = lane & 31, hi = lane >> 5, map = wid >> 2, c = wid & 3;
    LAS unsigned char* lds = F.lds; LAS float* tab = (LAS float*)(lds + TAB_OFF); LAS const float* hn = (LAS const float*)(lds + HN_OFF);
    LAS unsigned char* qbuf = lds + L_STG + wid * 8192;
    const float c15 = F.relb[15 * NH + h] * LOG2E;
    if (tid < 256) tab[tid] = F.relb[rel_bucket(tid - 192) * NH + h] * LOG2E - c15;
    const size_t rowq = (size_t)MP + (size_t)b * DEC_SEQ;
    stage_q(qbuf, F.QB(), rowq, 16, h, lane);
    const float* ck = F.ck + (size_t)b * PAST * NH * 128; const float* cv = F.cv + (size_t)b * PAST * NH * 128;
    constexpr int NTC = PAST / 64;
    float m = 0.f, l = 0.f; f32x16 o[1], negm;
#pragma unroll
    for (int r = 0; r < 16; ++r) { o[0][r] = 0.f; negm[r] = c15; }
#define SAMPLE_TILE(t) do { \
        int lane_ = lane; asm volatile("" : "+v"(lane_)); \
        const int r32_ = lane_ & 31, hi_ = lane_ >> 5, qi_ = r32_ & 15; \
        LAS const unsigned char* kbuf = lds + L_K + ((t) & 1) * TILEB; LAS const unsigned char* vbuf = lds + L_V + ((t) & 1) * TILEB; \
        const bool near = ((t) >= 30), first = ((t) == 0); \
        f32x16 p0, p1; \
        qk_map(p0, p1, kbuf, qbuf, map, negm, r32_, hi_); \
        if (near) add_bias(p0, p1, tab, 64 * (t) - (PAST + qi_) + 192 + 4 * hi_); \
        if ((t) == NTC) { _Pragma("unroll") for (int r = 0; r < 16; ++r) { if (crow(r, hi_) >= DEC_SEQ) p0[r] = -__builtin_inff(); p1[r] = -__builtin_inff(); } } \
        softmax_tile<1>(p0, p1, m, l, o, negm, c15, first); \
        const bf16x8 pf00 = pack8(p0, 0), pf01 = pack8(p0, 1), pf10 = pack8(p1, 0), pf11 = pack8(p1, 1); \
        o[0] = MFMA32(vfrag(vbuf, c, 0, 0, lane_), pf00, o[0]); o[0] = MFMA32(vfrag(vbuf, c, 0, 1, lane_), pf01, o[0]); \
        o[0] = MFMA32(vfrag(vbuf, c, 1, 0, lane_), pf10, o[0]); o[0] = MFMA32(vfrag(vbuf, c, 1, 1, lane_), pf11, o[0]); } while (0)
    float* sst = (float*)(F.ws + WS_SST) + ((size_t)((b * NH + h) * NWAVES + wid) * 18) * 64 + lane;
    if (tb > 0) { m = sst[0]; l = sst[64];
#pragma unroll
        for (int r = 0; r < 16; ++r) { o[0][r] = sst[(2 + r) * 64]; negm[r] = c15 - m; } }
    const int tce = te < NTC ? te : NTC;
    TileRegsF R0, R1;
    load_tile_f32(R0, ck, cv, tb * 64, h, tid); load_tile_f32(R1, ck, cv, (tb + 1) * 64, h, tid);
    store_tile_f32(R0, lds + L_K, lds + L_V, tid); if (tb + 2 < tce) load_tile_f32(R0, ck, cv, (tb + 2) * 64, h, tid);
    __syncthreads();
    for (int t = tb; t < tce; t += 2) {
        SAMPLE_TILE(t);
        store_tile_f32(R1, lds + L_K + TILEB, lds + L_V + TILEB, tid);
        if (t + 3 < tce) load_tile_f32(R1, ck, cv, (t + 3) * 64, h, tid);
        __syncthreads();
        SAMPLE_TILE(t + 1);
        if (t + 2 < tce) { store_tile_f32(R0, lds + L_K, lds + L_V, tid); if (t + 4 < tce) load_tile_f32(R0, ck, cv, (t + 4) * 64, h, tid); }
        else if (te > NTC) { TileRegs RN; load_tile_bf16(RN, F.KB(), F.VB(), rowq, h, tid, DEC_SEQ); store_tile_bf16(RN, lds + L_K, lds + L_V, tid); }
        __syncthreads();
    }
    if (te <= NTC) {
        sst[0] = m; sst[64] = l;
#pragma unroll
        for (int r = 0; r < 16; ++r) sst[(2 + r) * 64] = o[0][r];
        return;
    }
    SAMPLE_TILE(NTC);
    __syncthreads();
#undef SAMPLE_TILE
    l += __shfl_xor(l, 32);
    const float inv = 1.f / l;
    LAS float* stg = (LAS float*)(lds + L_K);
    if (r32 < 16) {
#pragma unroll
        for (int g = 0; g < 4; ++g) { const f32x4 v = {o[0][4 * g] * inv, o[0][4 * g + 1] * inv, o[0][4 * g + 2] * inv, o[0][4 * g + 3] * inv};
            *(LAS f32x4*)(stg + (map * 16 + r32) * 128 + 32 * c + 8 * g + 4 * hi) = v; }
    }
    __syncthreads();
    {
        const int q = tid >> 5, d4 = (tid & 31) * 4;
        const f32x4 s1 = *(LAS const f32x4*)(stg + q * 128 + d4), s2 = *(LAS const f32x4*)(stg + (16 + q) * 128 + d4);
        f32x4 v = s1 - s2 * lam; float ssq = (v.x * v.x + v.y * v.y) + (v.z * v.z + v.w * v.w);
#pragma unroll
        for (int x = 1; x < 32; x <<= 1) ssq += __shfl_xor(ssq, x);
        const float rs = 1.f / sqrtf(ssq * (1.f / DV) + EPS); const f32x4 hv = *(LAS const f32x4*)(hn + d4);
        bf16_t* ap = F.A3() + (rowq + q) * 2048 + h * 128 + d4; const u32x2 z = *(const u32x2*)ap;
        u32x2 w; w.x = pk_bf16(v.x * rs * hv.x * bf_lo(z.x), v.y * rs * hv.y * bf_hi(z.x)); w.y = pk_bf16(v.z * rs * hv.z * bf_lo(z.y), v.w * rs * hv.w * bf_hi(z.y));
        *(u32x2*)ap = w;
    }
    __syncthreads();
}
#undef MFMA32
}

__device__ __forceinline__ void unpack8(const u32x4 w, float (&f)[8]) { f[0] = bf_lo(w.x); f[1] = bf_hi(w.x); f[2] = bf_lo(w.y); f[3] = bf_hi(w.y); f[4] = bf_lo(w.z); f[5] = bf_hi(w.z); f[6] = bf_lo(w.w); f[7] = bf_hi(w.w); }
__device__ __forceinline__ void conv_phase(Frame& F, int widx, int nwg) {
    const int NTH = nwg * NWAVES * 64; const int gt = widx * (NWAVES * 64) + F.tid;
    const bf16_t* U = F.U(); bf16_t* A3 = F.A3();
    for (int it = gt; it < (M / 8) * 128; it += NTH) {
        const int row0 = (it >> 7) * 8, c8 = (it & 127) * 8;
        int t0, T; const float* st = nullptr; float* oc;
        if (row0 < MP) { t0 = row0 & (SEQ - 1); T = SEQ; oc = F.out + O_CP + (size_t)(row0 >> 11) * 2 * CONV_W; }
        else { const int sr = row0 - MP; t0 = sr & (DEC_SEQ - 1); T = DEC_SEQ; st = F.sconv + (size_t)(sr >> 4) * 2 * CONV_W; oc = F.out + O_CS + (size_t)(sr >> 4) * 2 * CONV_W; }
        u32x4 uw[10], gw[8];
#pragma unroll
        for (int i = 0; i < 8; ++i) { uw[i + 2] = *(const u32x4*)(U + (size_t)(row0 + i) * 1024 + c8); gw[i] = *(const u32x4*)(A3 + (size_t)(row0 + i) * 2048 + 1024 + c8); }
        float um2[8], um1[8];
        if (t0 >= 2) { uw[0] = *(const u32x4*)(U + (size_t)(row0 - 2) * 1024 + c8); uw[1] = *(const u32x4*)(U + (size_t)(row0 - 1) * 1024 + c8); unpack8(uw[0], um2); unpack8(uw[1], um1); }
        else if (st) { const f32x4 a = *(const f32x4*)(st + c8), b = *(const f32x4*)(st + c8 + 4), c = *(const f32x4*)(st + CONV_W + c8), d = *(const f32x4*)(st + CONV_W + c8 + 4);
            um2[0] = a.x; um2[1] = a.y; um2[2] = a.z; um2[3] = a.w; um2[4] = b.x; um2[5] = b.y; um2[6] = b.z; um2[7] = b.w; um1[0] = c.x; um1[1] = c.y; um1[2] = c.z; um1[3] = c.w; um1[4] = d.x; um1[5] = d.y; um1[6] = d.z; um1[7] = d.w; }
        else {
#pragma unroll
            for (int e = 0; e < 8; ++e) { um2[e] = 0.f; um1[e] = 0.f; } }
        float w0[8], w1[8], w2[8];
        { const f32x4 a = *(const f32x4*)(F.convw + c8), b = *(const f32x4*)(F.convw + c8 + 4); w0[0] = a.x; w0[1] = a.y; w0[2] = a.z; w0[3] = a.w; w0[4] = b.x; w0[5] = b.y; w0[6] = b.z; w0[7] = b.w; }
        { const f32x4 a = *(const f32x4*)(F.convw + CONV_W + c8), b = *(const f32x4*)(F.convw + CONV_W + c8 + 4); w1[0] = a.x; w1[1] = a.y; w1[2] = a.z; w1[3] = a.w; w1[4] = b.x; w1[5] = b.y; w1[6] = b.z; w1[7] = b.w; }
        { const f32x4 a = *(const f32x4*)(F.convw + 2 * CONV_W + c8), b = *(const f32x4*)(F.convw + 2 * CONV_W + c8 + 4); w2[0] = a.x; w2[1] = a.y; w2[2] = a.z; w2[3] = a.w; w2[4] = b.x; w2[5] = b.y; w2[6] = b.z; w2[7] = b.w; }
#pragma unroll
        for (int i = 0; i < 8; ++i) {
            float uc[8], gg[8], y[8]; unpack8(uw[i + 2], uc); unpack8(gw[i], gg);
#pragma unroll
            for (int e = 0; e < 8; ++e) y[e] = gg[e] * (w0[e] * um2[e] + w1[e] * um1[e] + w2[e] * uc[e]);
            u32x4 w; w.x = pk_bf16(y[0], y[1]); w.y = pk_bf16(y[2], y[3]); w.z = pk_bf16(y[4], y[5]); w.w = pk_bf16(y[6], y[7]); *(u32x4*)(A3 + (size_t)(row0 + i) * 2048 + 1024 + c8) = w;
            const int t = t0 + i;
            if (t >= T - 2) { float* op = oc + (size_t)(t - (T - 2)) * CONV_W + c8; *(f32x4*)op = (f32x4){uc[0], uc[1], uc[2], uc[3]}; *(f32x4*)(op + 4) = (f32x4){uc[4], uc[5], uc[6], uc[7]}; }
#pragma unroll
            for (int e = 0; e < 8; ++e) { um2[e] = um1[e]; um1[e] = uc[e]; }
        }
    }
}
__device__ __forceinline__ float att_setup(Frame& F) {
    float s1 = 0.f, s2 = 0.f;
    for (int i = 0; i < DQK; ++i) { s1 += F.lq1[i] * F.lk1[i]; s2 += F.lq2[i] * F.lk2[i]; }
    if (F.tid < DV) ((LAS float*)(F.lds + HN_OFF))[F.tid] = F.hnorm[F.tid] * (1.f - LAM_INIT);
    __syncthreads();
    return expf(s1) - expf(s2) + LAM_INIT;
}
constexpr int N_EARLY = 160, T_EARLY = 20;
__device__ __forceinline__ void p1_early_sample(Frame& F) {
    if (F.tid == 0) {
        unsigned sp = 0;
        while (__hip_atomic_load(F.ctl + CW_SREADY, RLX_AGENT) < 256u) { __builtin_amdgcn_s_sleep(8); if (++sp > (1u << 22)) { __hip_atomic_store(F.ctl + CW_TMO, 1u, RLX_AGENT); break; } }
        __builtin_amdgcn_fence(__ATOMIC_ACQUIRE, "agent");
        asm volatile("s_waitcnt vmcnt(0)" ::: "memory");
    }
    __syncthreads();
    const float lam = att_setup(F);
    const int u = (int)blockIdx.x - 96;
    att::sample_unit(F, u >> 3, u & 7, lam, 0, T_EARLY);
}
__device__ __forceinline__ void p2_attention(Frame& F) {
    const float lam = att_setup(F);
    if (F.G == 256) {
        const int c = blockIdx.x;
        if (F.mode == 0 || F.mode == 3) conv_phase(F, c, 256);
        if (c < 96) {
            const int bh = c / 3, j = c % 3, su = N_EARLY + c;
            if (F.mode == 0 || F.mode == 1) att::sample_unit(F, su >> 3, su & 7, lam, 0, 33);
            if (F.mode == 0 || F.mode == 2) { att::prompt_unit(F, bh >> 3, bh & 7, 10 - j, lam); if (j > 0) att::prompt_unit(F, bh >> 3, bh & 7, j - 1, lam); }
        } else {
            const int p = c - 96, bh = p / 5, j = p % 5;
            if (F.mode == 0 || F.mode == 2) {
                const int q0 = 15 - j, q1 = (j == 3) ? 7 : (j == 4) ? 6 : 3 + j;
                att::prompt_unit(F, bh >> 3, bh & 7, q0, lam); att::prompt_unit(F, bh >> 3, bh & 7, q1, lam); if (j == 4) att::prompt_unit(F, bh >> 3, bh & 7, 2, lam);
            }
            if (F.mode == 0 || F.mode == 1) att::sample_unit(F, p >> 3, p & 7, lam, T_EARLY, 33);
        }
    } else {
        conv_phase(F, F.vcu, F.G);
        for (int u = F.vcu; u < DEC_BATCH * NH; u += F.G) att::sample_unit(F, u >> 3, u & 7, lam, 0, 33);
        for (int u = F.vcu; u < BATCH * NH * 16; u += F.G) { const int bh = u >> 4, sq = u & 15; att::prompt_unit(F, bh >> 3, bh & 7, sq, lam); }
    }
}
__device__ __forceinline__ void p5_post(Frame& F) {
    const int gw = F.vcu * NWAVES + F.wave, NGW = F.G * NWAVES;
    for (int m = gw; m < M; m += NGW) {
        const GAS u32x4* yr = (const GAS u32x4*)(F.Y() + (size_t)m * D_MODEL) + F.lane;
        const float* xrow = (m < MP) ? F.xp + (size_t)m * D_MODEL : F.xs + (size_t)(m - MP) * D_MODEL;
        float* orow = (m < MP) ? F.out + O_YP + (size_t)m * D_MODEL : F.out + O_YS + (size_t)(m - MP) * D_MODEL;
        u32x4 yw[4]; f32x4 xv[4][2]; float s = 0.f;
#pragma unroll
        for (int j = 0; j < 4; ++j) { yw[j] = yr[64 * j]; const GAS f32x4* xr = (const GAS f32x4*)(xrow + 512 * j + 8 * F.lane); xv[j][0] = xr[0]; xv[j][1] = xr[1]; }
        float y[4][8];
#pragma unroll
        for (int j = 0; j < 4; ++j) { y[j][0] = bf_lo(yw[j].x); y[j][1] = bf_hi(yw[j].x); y[j][2] = bf_lo(yw[j].y); y[j][3] = bf_hi(yw[j].y); y[j][4] = bf_lo(yw[j].z); y[j][5] = bf_hi(yw[j].z); y[j][6] = bf_lo(yw[j].w); y[j][7] = bf_hi(yw[j].w);
#pragma unroll
            for (int e = 0; e < 8; ++e) s += y[j][e] * y[j][e]; }
        const float rs = 1.f / sqrtf(wave_sum(s) * (1.f / D_MODEL) + EPS);
#pragma unroll
        for (int j = 0; j < 4; ++j) { const GAS f32x4* gr = (const GAS f32x4*)(F.npost + 512 * j + 8 * F.lane); const f32x4 g0 = gr[0], g1 = gr[1];
            GAS f32x4* op = (GAS f32x4*)(orow + 512 * j + 8 * F.lane);
            op[0] = xv[j][0] + (f32x4){y[j][0], y[j][1], y[j][2], y[j][3]} * rs * g0; op[1] = xv[j][1] + (f32x4){y[j][4], y[j][5], y[j][6], y[j][7]} * rs * g1; }
    }
}

constexpr int N_LAUNCHES = MK_N_LAUNCHES, PER_PHASE = 6;
struct Args { const float* in[18]; float* out; unsigned char* ws; int ph_lo, ph_hi, li, pad; };
__global__ void __launch_bounds__(NWAVES * 64, 2) mk_fwd(Args args) {
    extern __shared__ __attribute__((aligned(16))) unsigned char lds[];
    Frame F;
    F.lds = (LAS unsigned char*)lds;
    F.MISC = (volatile LAS unsigned*)(F.lds + MISC_OFF);
    F.tid = threadIdx.x; F.lane = F.tid & 63; F.wave = __builtin_amdgcn_readfirstlane(F.tid >> 6);
    F.mode = args.pad; F.G = gridDim.x; { const int bx = blockIdx.x; F.vcu = (F.G % 8 == 0) ? (bx % 8) * (F.G / 8) + bx / 8 : bx; }
    unsigned char* ws = args.ws;
    F.ctl = (gu32*)(ws + WS_CTL);
    F.xp = args.in[0]; F.xs = args.in[1]; F.ck = args.in[2]; F.cv = args.in[3]; F.sconv = args.in[4]; F.npre = args.in[5]; F.npost = args.in[6]; F.w_in = args.in[7];
    F.lq1 = args.in[8]; F.lk1 = args.in[9]; F.lq2 = args.in[10]; F.lk2 = args.in[11]; F.hnorm = args.in[12]; F.convw = args.in[13]; F.wpa = args.in[14]; F.wpc = args.in[15];
    F.wout = args.in[16]; F.relb = args.in[17]; F.out = args.out;
    F.ws = ws;
    for (int u = F.tid; u < 512 / 4; u += NWAVES * 64) ((LAS unsigned*)(F.lds + LDSCTL_OFF))[u] = 0u;
    __syncthreads();
    XcdBarrier bar; bar.bar = (unsigned*)(F.ctl + CW_BAR); bar.x = 0; bar.st = nullptr;
    if (N_LAUNCHES != PER_PHASE) bar = xcd_barrier_post((unsigned*)(F.ctl + CW_BAR) + args.li * XCD_BAR_WORDS, F.MISC + 8);
#define GRID_BAR() do { if (N_LAUNCHES != PER_PHASE) xcd_barrier(bar); } while (0)
    const int lo = args.ph_lo, hi = args.ph_hi;
#ifndef PH_MASK
#define PH_MASK 63
#endif
#define IN(k) (((PH_MASK >> (k)) & 1) && lo <= (k) && (k) < hi)
#define BOTH(k) (IN(k) && IN((k) + 1))
    if (IN(0)) { p0_prologue(F); if (BOTH(0)) GRID_BAR(); }
    if (IN(1)) {
        pg8::Gemm g{F.XN(), F.W1T(), M, N_IN, D_MODEL};
        pg8::Epi1 E{F.QB(), F.KB(), F.VB(), F.A3(), F.U(), F.RB(), F.S2(), F.out};
        if (F.G == 256) {
            pg8::P1Order S; S.init(F.G, (int)blockIdx.x, (unsigned*)(F.ctl + CW_SREADY));
            pg8::gemm_phase<pg8::Epi1, pg8::P1Order, true, true>(F.lds, g, S, E);
            if (blockIdx.x >= 96 && F.mode == 0) p1_early_sample(F);
        } else {
            pg8::StaticOrder S; S.init(M, N_IN, F.G, (int)blockIdx.x);
            pg8::gemm_phase<pg8::Epi1, pg8::StaticOrder, true, true>(F.lds, g, S, E);
        }
        if (BOTH(1)) GRID_BAR();
    }
    if (IN(2)) { p2_attention(F); if (BOTH(2)) GRID_BAR(); }
    if (IN(3)) {
        pg8::Gemm g{F.A3(), F.W3T(), M, D_MODEL, D_MODEL}; pg8::StaticOrder S; S.init(M, D_MODEL, F.G, (int)blockIdx.x);
        pg8::Epi3 E{F.RB(), F.S2(), F.MB()};
        S.limit = (S.nwg / F.G) * F.G;
        pg8::gemm_phase<pg8::Epi3, pg8::StaticOrder, true, true>(F.lds, g, S, E);
        if (F.mode != 4) pg8::gemm_tail<pg8::Epi3>(F.lds, g, S, E);
        if (BOTH(3)) GRID_BAR();
    }
    if (IN(4)) {
        pg8::Gemm g{F.MB(), F.W4T(), M, D_MODEL, D_MODEL}; pg8::StaticOrder S; S.init(M, D_MODEL, F.G, (int)blockIdx.x);
        pg8::EpiY E{F.Y()};
        S.limit = (S.nwg / F.G) * F.G;
        pg8::gemm_phase<pg8::EpiY, pg8::StaticOrder, true, true>(F.lds, g, S, E);
        if (F.mode != 4) pg8::gemm_tail<pg8::EpiY>(F.lds, g, S, E);
        if (BOTH(4)) GRID_BAR();
    }
    if (IN(5)) { p5_post(F); }
#undef IN
#undef BOTH
}

extern "C" void kernel_launch(void* const* d_in, const int* in_sizes, int n_in, void* d_out, int out_size, void* d_ws, size_t ws_size, hipStream_t stream) {
    static int grid = 0;
    if (grid == 0) {
        if (n_in != 18 || (size_t)out_size != O_END || ws_size < WS_END) { fprintf(stderr, "kernel_launch: unexpected sizes n_in %d out %d ws %zu\n", n_in, out_size, ws_size); grid = -1; return; }
        int dev = 0, cus = 0, per_cu = 0;
        if (hipGetDevice(&dev) != hipSuccess || hipDeviceGetAttribute(&cus, hipDeviceAttributeMultiprocessorCount, dev) != hipSuccess) { grid = -1; return; }
        if (hipFuncSetAttribute((const void*)mk_fwd, hipFuncAttributeMaxDynamicSharedMemorySize, LDS_BYTES) != hipSuccess) { fprintf(stderr, "kernel_launch: hipFuncSetAttribute failed\n"); grid = -1; return; }
        if (hipOccupancyMaxActiveBlocksPerMultiprocessor(&per_cu, (const void*)mk_fwd, NWAVES * 64, LDS_BYTES) != hipSuccess || per_cu < 1) { fprintf(stderr, "kernel_launch: occupancy query says %d\n", per_cu); (void)hipGetLastError(); grid = -1; return; }
        grid = cus;
    }
    if (grid < 0) return;
    (void)hipMemsetAsync((char*)d_ws + WS_CTL, 0, CTL_ZERO_BYTES, stream);
    Args a{};
    for (int i = 0; i < 18; ++i) a.in[i] = (const float*)d_in[i];
    a.out = (float*)d_out; a.ws = (unsigned char*)d_ws;
    for (int li = 0; li < N_LAUNCHES; ++li) {
        a.ph_lo = (N_LAUNCHES == PER_PHASE) ? li : 0; a.ph_hi = (N_LAUNCHES == PER_PHASE) ? li + 1 : PER_PHASE; a.li = li;
        hipLaunchKernelGGL(mk_fwd, dim3(grid), dim3(NWAVES * 64), LDS_BYTES, stream, a);
    }
#if PROBE_LO >= 0
    a.ph_lo = PROBE_LO; a.ph_hi = PROBE_HI; a.li = 1; a.pad = PROBE_MODE;
    hipLaunchKernelGGL(mk_fwd, dim3(grid), dim3(NWAVES * 64), LDS_BYTES, stream, a);
#endif
}
```

```cpp
#include <hip/hip_runtime.h>
#include <cstdio>
#include <cstdint>

#ifndef MK_N_LAUNCHES
#define MK_N_LAUNCHES 1
#endif
#define PROBE_LO -1
#define PROBE_HI -1
#define PROBE_MODE 0

constexpr int D_MODEL = 2048, BATCH = 4, SEQ = 2048, DEC_BATCH = 32, DEC_SEQ = 16, PAST = 2048, NH = 8, DQK = 64, DV = 128, ATT_W = 1024, CONV_W = 1024, N_IN = 12288;
constexpr int MP = BATCH * SEQ, MS = DEC_BATCH * DEC_SEQ, M = MP + MS;
constexpr float EPS = 1e-6f, LOG2E = 1.4426950408889634f, QSCALE = 0.125f * LOG2E, LAM_INIT = 0.2f;
constexpr size_t O_YP = 0, O_YS = O_YP + (size_t)MP * D_MODEL, O_KP = O_YS + (size_t)MS * D_MODEL, O_VP = O_KP + (size_t)MP * 1024, O_CP = O_VP + (size_t)MP * 1024,
                 O_KS = O_CP + (size_t)BATCH * 2 * CONV_W, O_VS = O_KS + (size_t)MS * 1024, O_CS = O_VS + (size_t)MS * 1024, O_END = O_CS + (size_t)DEC_BATCH * 2 * CONV_W;

constexpr size_t MiB = 1u << 20;
constexpr size_t WS_CTL = 0, CTL_ZERO_BYTES = 1 * MiB;
constexpr size_t WS_W1T = 2 * MiB, WS_W3T = 50 * MiB, WS_W4T = 58 * MiB, WS_XN = 66 * MiB, WS_QB = 100 * MiB, WS_KB = 117 * MiB, WS_VB = 134 * MiB,
                 WS_A3 = 151 * MiB, WS_U = 185 * MiB, WS_RB = 202 * MiB, WS_S2 = 236 * MiB, WS_MB = 270 * MiB, WS_Y = 304 * MiB, WS_END = 372 * MiB;
constexpr int CW_TMO = 0, CW_BAR = 4096;

constexpr int RING_BYTES = 131072, LDSCTL_OFF = RING_BYTES, MISC_OFF = LDSCTL_OFF + 320, TAB_OFF = LDSCTL_OFF + 512, HN_OFF = TAB_OFF + 1024, LDS_BYTES = 147456;
constexpr int NWAVES = 8;

#define GAS __attribute__((address_space(1)))
#define LAS __attribute__((address_space(3)))
typedef unsigned short bf16_t;
typedef short bf16x8 __attribute__((ext_vector_type(8)));
typedef short s16x4 __attribute__((ext_vector_type(4)));
typedef float f32x4 __attribute__((ext_vector_type(4)));
typedef float f32x16 __attribute__((ext_vector_type(16)));
typedef unsigned u32x4 __attribute__((ext_vector_type(4)));
typedef unsigned u32x2 __attribute__((ext_vector_type(2)));
typedef float f32x2_t __attribute__((ext_vector_type(2)));
typedef __bf16 bf16x2_t __attribute__((ext_vector_type(2)));
typedef GAS unsigned gu32;
#define RLX_AGENT __ATOMIC_RELAXED, __HIP_MEMORY_SCOPE_AGENT
#define LDS_WAIT() asm volatile("s_waitcnt lgkmcnt(0)" ::: "memory")
#define VM_WAIT() asm volatile("s_waitcnt vmcnt(0)" ::: "memory")

__device__ __forceinline__ unsigned pk_bf16(float lo, float hi) { f32x2_t v = {lo, hi}; bf16x2_t b = __builtin_convertvector(v, bf16x2_t); return __builtin_bit_cast(unsigned, b); }
__device__ __forceinline__ float bf_lo(unsigned w) { return __uint_as_float(w << 16); }
__device__ __forceinline__ float bf_hi(unsigned w) { return __uint_as_float(w & 0xffff0000u); }
__device__ __forceinline__ float fast_exp2(float x) { return __builtin_amdgcn_exp2f(x); }
__device__ __forceinline__ float fast_rcp(float x) { return __builtin_amdgcn_rcpf(x); }
__device__ __forceinline__ float sigmoidf_(float x) { x = fminf(fmaxf(x, -30.f), 30.f); return fast_rcp(1.f + fast_exp2(-x * LOG2E)); }
__device__ __forceinline__ float siluf_(float x) { return x * sigmoidf_(x); }

__host__ __device__ __forceinline__ int orig_col(int v) {
    if (v < 4096) return v;
    const int vl = v & 255;
    if (v < 8192) { const int j = (v - 4096) >> 8, bj = vl >> 7, wc = (vl >> 5) & 3, fq = (vl >> 3) & 3, n = (vl >> 2) & 1, e = vl & 3; return 4096 + 1024 * (2 * bj + n) + 64 * j + 16 * wc + 4 * fq + e; }
    const int j = (v - 8192) >> 8, bj = vl >> 7; return 8192 + 2048 * bj + 128 * j + (vl & 127);
}

namespace pg8 {
#define PG8_LAS __attribute__((address_space(3)))
constexpr int BM = 256, BK = 64, HALF = 128, HTB = HALF * BK * 2, STAGE_BYTES = 8 * HTB, NXCD = 8, WGM = 8;
__host__ __device__ __forceinline__ int lds_byte(int r, int c) { const int st = (r >> 4) * 2 + (c >> 5), rr = r & 15, cc = c & 31, ob = rr * 64 + cc * 2; return st * 1024 + (ob ^ (((ob >> 9) & 1) << 5)); }
__host__ __device__ __forceinline__ void stage_rc(int b, int& R, int& C) { const int st = b / 1024, sb = b % 1024, swz = sb ^ (((sb >> 9) & 1) << 5); R = (st >> 1) * 16 + swz / 64; C = (st & 1) * 32 + (swz % 64) / 2; }
__host__ __device__ __forceinline__ int perm32(int rho) { const int n = rho >> 4, i = rho & 15; return 8 * (i >> 2) + 4 * n + (i & 3); }
struct Unit { int pm, pn; };
struct Gemm { const bf16_t* A; const bf16_t* Bt; int M, N, K; };
struct StaticOrder {
    int nM, nN, nwg, G, c, limit;
    __host__ __device__ void init(int M_, int N_, int G_, int c_) { nM = M_ / BM; nN = N_ / BM; nwg = nM * nN; G = G_; c = c_; limit = nwg; }
    __host__ __device__ void unit_of(int L, Unit& u) const {
        int wgid = L; { const int q = nwg / NXCD, r = nwg % NXCD, xcd = wgid % NXCD, off = wgid / NXCD; wgid = (xcd < r ? xcd * (q + 1) : r * (q + 1) + (xcd - r) * q) + off; }
        const int nig = WGM * nN, gid = wgid / nig, fm = gid * WGM, gsz = (nM - fm) < WGM ? (nM - fm) : WGM;
        u.pm = fm + ((wgid % nig) % gsz); u.pn = (wgid % nig) / gsz;
    }
    __host__ __device__ bool next(int i, Unit& u) const {
        const long L = (long)i * G + c; if (L >= limit) return false;
        int wgid = (int)L; { const int q = nwg / NXCD, r = nwg % NXCD, xcd = wgid % NXCD, off = wgid / NXCD; wgid = (xcd < r ? xcd * (q + 1) : r * (q + 1) + (xcd - r) * q) + off; }
        const int nig = WGM * nN, gid = wgid / nig, fm = gid * WGM, gsz = (nM - fm) < WGM ? (nM - fm) : WGM;
        u.pm = fm + ((wgid % nig) % gsz); u.pn = (wgid % nig) / gsz; return true;
    }
    __device__ __forceinline__ void a_ready(const Unit&) const {}
    __device__ __forceinline__ void done(const Unit&) const {}
};

struct Epi1 {
    static constexpr bool PERM = true, AFTER_DRAIN = false, HAS_MID = false; static constexpr int MID_T = 0;
    bf16_t *Qb, *Kb, *Vb, *A3, *U, *R, *S2; float* out;
    __device__ __forceinline__ void mid(f32x4 (&)[2][2][4][2], const Unit&, int, int, int, int) const {}
    __device__ __forceinline__ void operator()(const f32x4 (&acc)[2][2][4][2], const Unit& u, int wr, int wc, int fr, int fq) const {
        const int row0 = u.pm * BM + wr * 64 + fr, pn = u.pn, cl = wc * 32 + 8 * fq;
        if (pn < 4) {
#pragma unroll
            for (int ai = 0; ai < 2; ++ai)
#pragma unroll
                for (int m = 0; m < 4; ++m) { bf16_t* rp = Qb + (size_t)(row0 + ai * HALF + m * 16) * 1024 + pn * 256 + cl;
#pragma unroll
                    for (int bj = 0; bj < 2; ++bj) { const f32x4 v0 = acc[ai][bj][m][0] * QSCALE, v1 = acc[ai][bj][m][1] * QSCALE;
                        u32x4 w; w.x = pk_bf16(v0[0], v0[1]); w.y = pk_bf16(v0[2], v0[3]); w.z = pk_bf16(v1[0], v1[1]); w.w = pk_bf16(v1[2], v1[3]); *(u32x4*)(rp + bj * HALF) = w; } }
        } else if (pn < 12) {
            const bool isk = pn < 8; const int ct = (isk ? pn - 4 : pn - 8) * 256 + cl;
            bf16_t* B = isk ? Kb : Vb;
            float* O = (u.pm < MP / BM) ? out + (isk ? O_KP : O_VP) : out + (isk ? O_KS : O_VS) - (size_t)MP * 1024;
#pragma unroll
            for (int ai = 0; ai < 2; ++ai)
#pragma unroll
                for (int m = 0; m < 4; ++m) { const size_t ro = (size_t)(row0 + ai * HALF + m * 16) * 1024 + ct;
#pragma unroll
                    for (int bj = 0; bj < 2; ++bj) { const f32x4 v0 = acc[ai][bj][m][0], v1 = acc[ai][bj][m][1];
                        *(f32x4*)(O + ro + bj * HALF) = v0; *(f32x4*)(O + ro + bj * HALF + 4) = v1;
                        u32x4 w; w.x = pk_bf16(v0[0], v0[1]); w.y = pk_bf16(v0[2], v0[3]); w.z = pk_bf16(v1[0], v1[1]); w.w = pk_bf16(v1[2], v1[3]); *(u32x4*)(B + ro + bj * HALF) = w; } }
        } else if (pn < 16) {
#pragma unroll
            for (int ai = 0; ai < 2; ++ai)
#pragma unroll
                for (int m = 0; m < 4; ++m) { bf16_t* rp = A3 + (size_t)(row0 + ai * HALF + m * 16) * 2048 + (pn - 12) * 256 + cl;
#pragma unroll
                    for (int bj = 0; bj < 2; ++bj) { const f32x4 a = acc[ai][bj][m][0], b = acc[ai][bj][m][1];
                        u32x4 w; w.x = pk_bf16(siluf_(a[0]), siluf_(a[1])); w.y = pk_bf16(siluf_(a[2]), siluf_(a[3])); w.z = pk_bf16(siluf_(b[0]), siluf_(b[1])); w.w = pk_bf16(siluf_(b[2]), siluf_(b[3]));
                        *(u32x4*)(rp + bj * HALF) = w; } }
        } else if (pn < 32) {
            const int ch0 = (pn - 16) * 64 + wc * 16 + 4 * fq;
#pragma unroll
            for (int ai = 0; ai < 2; ++ai)
#pragma unroll
                for (int m = 0; m < 4; ++m) { const size_t row = (size_t)(row0 + ai * HALF + m * 16);
                    const f32x4 bg = acc[ai][0][m][0], cg = acc[ai][0][m][1], hh = acc[ai][1][m][0], zc = acc[ai][1][m][1];
                    const f32x4 uu = cg * hh; u32x2 wu; wu.x = pk_bf16(uu[0], uu[1]); wu.y = pk_bf16(uu[2], uu[3]); *(u32x2*)(U + row * 1024 + ch0) = wu;
                    u32x2 wg; wg.x = pk_bf16(bg[0] * siluf_(zc[0]), bg[1] * siluf_(zc[1])); wg.y = pk_bf16(bg[2] * siluf_(zc[2]), bg[3] * siluf_(zc[3])); *(u32x2*)(A3 + row * 2048 + 1024 + ch0) = wg; }
        } else {
            const int ch0 = (pn - 32) * 128 + cl;
#pragma unroll
            for (int ai = 0; ai < 2; ++ai)
#pragma unroll
                for (int m = 0; m < 4; ++m) { const size_t ro = (size_t)(row0 + ai * HALF + m * 16) * 2048 + ch0; float rr[8], ss[8];
#pragma unroll
                    for (int n = 0; n < 2; ++n)
#pragma unroll
                        for (int e = 0; e < 4; ++e) { const float ga = fminf(fmaxf(acc[ai][0][m][n][e], -30.f), 30.f), gc = fminf(fmaxf(acc[ai][1][m][n][e], -30.f), 30.f);
                            const float ea = 1.f + fast_exp2(-ga * LOG2E), ec = 1.f + fast_exp2(-gc * LOG2E); rr[4 * n + e] = ec * fast_rcp(ea); ss[4 * n + e] = fast_rcp(ec); }
                    u32x4 w; w.x = pk_bf16(rr[0], rr[1]); w.y = pk_bf16(rr[2], rr[3]); w.z = pk_bf16(rr[4], rr[5]); w.w = pk_bf16(rr[6], rr[7]); *(u32x4*)(R + ro) = w;
                    u32x4 s; s.x = pk_bf16(ss[0], ss[1]); s.y = pk_bf16(ss[2], ss[3]); s.z = pk_bf16(ss[4], ss[5]); s.w = pk_bf16(ss[6], ss[7]); *(u32x4*)(S2 + ro) = s; }
        }
    }
};
struct Epi3 {
    static constexpr bool PERM = true, AFTER_DRAIN = false, HAS_MID = true; static constexpr int MID_T = 16;
    const bf16_t *R, *S2; bf16_t* Mb;
    __device__ __forceinline__ void mid(f32x4 (&acc)[2][2][4][2], const Unit& u, int wr, int wc, int fr_, int fq_) const {
        int fr = fr_, fq = fq_; asm volatile("" : "+v"(fr), "+v"(fq));
        const bf16_t* base = R + (size_t)(u.pm * BM + wr * 64 + fr) * 2048 + (u.pn * BM + wc * 32 + 8 * fq);
#pragma unroll
        for (int ai = 0; ai < 2; ++ai)
#pragma unroll
            for (int mp = 0; mp < 2; ++mp) {
#pragma unroll
                for (int mm = 0; mm < 2; ++mm) { const int m = 2 * mp + mm; const bf16_t* rp = base + (size_t)(ai * HALF + m * 16) * 2048;
#pragma unroll
                    for (int bj = 0; bj < 2; ++bj) { const u32x4 w = *(const u32x4*)(rp + bj * HALF);
                        acc[ai][bj][m][0] *= (f32x4){bf_lo(w.x), bf_hi(w.x), bf_lo(w.y), bf_hi(w.y)}; acc[ai][bj][m][1] *= (f32x4){bf_lo(w.z), bf_hi(w.z), bf_lo(w.w), bf_hi(w.w)}; } }
                asm volatile("" ::: "memory"); }
    }
    __device__ __forceinline__ void operator()(const f32x4 (&acc)[2][2][4][2], const Unit& u, int wr, int wc, int fr_, int fq_) const {
        int fr = fr_, fq = fq_; asm volatile("" : "+v"(fr), "+v"(fq));
        const size_t ro0 = (size_t)(u.pm * BM + wr * 64 + fr) * 2048 + (u.pn * BM + wc * 32 + 8 * fq);
#pragma unroll
        for (int ai = 0; ai < 2; ++ai)
#pragma unroll
            for (int mp = 0; mp < 2; ++mp) {
#pragma unroll
                for (int mm = 0; mm < 2; ++mm) { const int m = 2 * mp + mm; const size_t ro = ro0 + (size_t)(ai * HALF + m * 16) * 2048;
#pragma unroll
                    for (int bj = 0; bj < 2; ++bj) { const u32x4 s = *(const u32x4*)(S2 + ro + bj * HALF); const f32x4 a = acc[ai][bj][m][0], b = acc[ai][bj][m][1];
                        u32x4 w; w.x = pk_bf16(a[0] * bf_lo(s.x), a[1] * bf_hi(s.x)); w.y = pk_bf16(a[2] * bf_lo(s.y), a[3] * bf_hi(s.y)); w.z = pk_bf16(b[0] * bf_lo(s.z), b[1] * bf_hi(s.z)); w.w = pk_bf16(b[2] * bf_lo(s.w), b[3] * bf_hi(s.w));
                        *(u32x4*)(Mb + ro + bj * HALF) = w; } }
                asm volatile("" ::: "memory"); }
    }
    __device__ __forceinline__ void tail_mid(f32x4 (&acc)[2], int row, int col) const {
#pragma unroll
        for (int n = 0; n < 2; ++n) { const u32x2 r = *(const u32x2*)(R + (size_t)row * 2048 + col + 16 * n); acc[n] *= (f32x4){bf_lo(r.x), bf_hi(r.x), bf_lo(r.y), bf_hi(r.y)}; }
    }
    __device__ __forceinline__ void tail_out(const f32x4 (&acc)[2], int row, int col) const {
#pragma unroll
        for (int n = 0; n < 2; ++n) { const size_t ro = (size_t)row * 2048 + col + 16 * n; const u32x2 t = *(const u32x2*)(S2 + ro);
            u32x2 w; w.x = pk_bf16(acc[n][0] * bf_lo(t.x), acc[n][1] * bf_hi(t.x)); w.y = pk_bf16(acc[n][2] * bf_lo(t.y), acc[n][3] * bf_hi(t.y)); *(u32x2*)(Mb + ro) = w; }
    }
};
struct EpiY {
    static constexpr bool PERM = true, AFTER_DRAIN = false, HAS_MID = false; static constexpr int MID_T = 0;
    bf16_t* Y;
    __device__ __forceinline__ void mid(f32x4 (&)[2][2][4][2], const Unit&, int, int, int, int) const {}
    __device__ __forceinline__ void operator()(const f32x4 (&acc)[2][2][4][2], const Unit& u, int wr, int wc, int fr, int fq) const {
        const int row0 = u.pm * BM + wr * 64 + fr, col0 = u.pn * BM + wc * 32 + 8 * fq;
#pragma unroll
        for (int ai = 0; ai < 2; ++ai)
#pragma unroll
            for (int m = 0; m < 4; ++m) { bf16_t* rp = Y + (size_t)(row0 + ai * HALF + m * 16) * 2048 + col0;
#pragma unroll
                for (int bj = 0; bj < 2; ++bj) { const f32x4 a = acc[ai][bj][m][0], b = acc[ai][bj][m][1];
                    u32x4 w; w.x = pk_bf16(a[0], a[1]); w.y = pk_bf16(a[2], a[3]); w.z = pk_bf16(b[0], b[1]); w.w = pk_bf16(b[2], b[3]); *(u32x4*)(rp + bj * HALF) = w; } }
    }
    __device__ __forceinline__ void tail_mid(f32x4 (&)[2], int, int) const {}
    __device__ __forceinline__ void tail_out(const f32x4 (&acc)[2], int row, int col) const {
#pragma unroll
        for (int n = 0; n < 2; ++n) { u32x2 w; w.x = pk_bf16(acc[n][0], acc[n][1]); w.y = pk_bf16(acc[n][2], acc[n][3]); *(u32x2*)(Y + (size_t)row * 2048 + col + 16 * n) = w; }
    }
};

template <class Epi, class Sched, bool ALIGN_EPI = false, bool SP2 = false>
__device__ __forceinline__ void gemm_phase(PG8_LAS unsigned char* lds, const Gemm g, const Sched& S, const Epi& E) {
    const int tid = threadIdx.x, wid = __builtin_amdgcn_readfirstlane(tid >> 6), lane = tid & 63, wr = wid >> 2, wc = wid & 3, fr = lane & 15, fq = lane >> 4;
    const int K = g.K, nt = K / BK;
    unsigned voffA[2], voffB[2];
#pragma unroll
    for (int i = 0; i < 2; ++i) { int R, C; stage_rc(tid * 16 + i * 8192, R, C); const int Rb = Epi::PERM ? ((R & ~31) + perm32(R & 31)) : R;
        voffA[i] = (unsigned)(R * K + C) * 2u; voffB[i] = (unsigned)(Rb * K + C) * 2u; }
    const size_t kstep = (size_t)(BK * 2);
    const size_t hstep = (size_t)HALF * K * 2;
    const size_t tstep = 2 * hstep;
    const unsigned ldsw = (unsigned)wid * 1024u;
    const int aoff = lds_byte(wr * 64 + fr, fq * 8), boff = lds_byte(wc * 32 + fr, fq * 8);
#define PG8_SA(b, h) (((b) * 2 + (h)) * HTB)
#define PG8_SB(b, h) ((4 + (b) * 2 + (h)) * HTB)
#define PG8_STAGE(bufoff, gbase, voff) do { _Pragma("unroll") for (int _i = 0; _i < 2; ++_i) \
        __builtin_amdgcn_global_load_lds((const unsigned*)((const char*)(gbase) + (voff)[_i]), (PG8_LAS unsigned*)(lds + (bufoff) + ldsw + _i * 8192), 16, 0, 0); } while (0)
#define PG8_LDA(dst, b, h) do { _Pragma("unroll") for (int m = 0; m < 4; ++m) _Pragma("unroll") for (int k = 0; k < 2; ++k) dst[m][k] = *(const PG8_LAS bf16x8*)(lds + PG8_SA(b, h) + aoff + m * 2048 + k * 1024); } while (0)
#define PG8_LDB(dst, b, h) do { _Pragma("unroll") for (int n = 0; n < 2; ++n) _Pragma("unroll") for (int k = 0; k < 2; ++k) dst[n][k] = *(const PG8_LAS bf16x8*)(lds + PG8_SB(b, h) + boff + n * 2048 + k * 1024); } while (0)
#define PG8_MMA(ai, bj, At, Bt) do { __builtin_amdgcn_s_setprio(1); _Pragma("unroll") for (int m = 0; m < 4; ++m) _Pragma("unroll") for (int n = 0; n < 2; ++n) _Pragma("unroll") for (int k = 0; k < 2; ++k) \
        acc[ai][bj][m][n] = __builtin_amdgcn_mfma_f32_16x16x32_bf16(Bt[n][k], At[m][k], acc[ai][bj][m][n], 0, 0, 0); __builtin_amdgcn_s_setprio(0); } while (0)
#define PG8_WAIT_V(n) asm volatile("s_waitcnt vmcnt(" #n ")" ::: "memory")
#define PG8_WAIT_L(n) asm volatile("s_waitcnt lgkmcnt(" #n ")" ::: "memory")
#define PG8_BAR __builtin_amdgcn_s_barrier()
#define PG8_SCHED __builtin_amdgcn_sched_barrier(0)
    Unit cur, nxt; int ui = 0;
    if (!S.next(0, cur)) return;
    f32x4 acc[2][2][4][2];
#pragma unroll
    for (int a = 0; a < 2; ++a)
#pragma unroll
        for (int b = 0; b < 2; ++b)
#pragma unroll
            for (int m = 0; m < 4; ++m)
#pragma unroll
                for (int n = 0; n < 2; ++n) acc[a][b][m][n] = (f32x4){0.f, 0.f, 0.f, 0.f};
    bf16x8 At[4][2], B0[2][2], B1[2][2];
    const char* cA = (const char*)g.A + (size_t)cur.pm * tstep; const char* cB = (const char*)g.Bt + (size_t)cur.pn * tstep;
    S.a_ready(cur);
    if constexpr (SP2) {
        PG8_STAGE(PG8_SB(0, 0), cB, voffB); PG8_STAGE(PG8_SB(0, 1), cB + hstep, voffB); PG8_STAGE(PG8_SA(0, 0), cA, voffA); PG8_STAGE(PG8_SA(0, 1), cA + hstep, voffA);
        if (wr == 1) PG8_BAR;
        PG8_WAIT_V(2); PG8_BAR;
        PG8_STAGE(PG8_SB(1, 0), cB + kstep, voffB); PG8_STAGE(PG8_SA(1, 0), cA + kstep, voffA); PG8_STAGE(PG8_SB(1, 1), cB + hstep + kstep, voffB);
        PG8_WAIT_V(6); PG8_BAR;
    } else {
        PG8_STAGE(PG8_SB(0, 0), cB, voffB); PG8_STAGE(PG8_SA(0, 0), cA, voffA); PG8_STAGE(PG8_SB(0, 1), cB + hstep, voffB); PG8_STAGE(PG8_SA(0, 1), cA + hstep, voffA);
        if (wr == 1) PG8_BAR;
        PG8_WAIT_V(4); PG8_BAR;
        PG8_STAGE(PG8_SB(1, 0), cB + kstep, voffB); PG8_STAGE(PG8_SA(1, 0), cA + kstep, voffA); PG8_STAGE(PG8_SB(1, 1), cB + hstep + kstep, voffB);
        PG8_WAIT_V(6); PG8_BAR;
    }
    for (;;) {
        const bool has_next = S.next(ui + 1, nxt);
        const char* nA = has_next ? (const char*)g.A + (size_t)nxt.pm * tstep : cA; const char* nB = has_next ? (const char*)g.Bt + (size_t)nxt.pn * tstep : cB;
        for (int t = 0; t < nt; t += 2) {
            if constexpr (Epi::HAS_MID) { if (t == Epi::MID_T) E.mid(acc, cur, wr, wc, fr, fq); }
            const bool last = (t == nt - 2);
            const char* a1 = cA + (size_t)(t + 1) * kstep;
            const char* a2 = last ? nA : cA + (size_t)(t + 2) * kstep; const char* b2 = last ? nB : cB + (size_t)(t + 2) * kstep;
            const char* a3 = a2 + kstep; const char* b3 = b2 + kstep;
            if (last && has_next) S.a_ready(nxt);
            if constexpr (SP2) {
            PG8_LDB(B0, 0, 0); PG8_LDB(B1, 0, 1); PG8_SCHED; PG8_LDA(At, 0, 0); PG8_STAGE(PG8_SA(1, 1), a1 + hstep, voffA);
            PG8_WAIT_V(8); PG8_WAIT_L(0); PG8_BAR; PG8_MMA(0, 0, At, B0); PG8_MMA(0, 1, At, B1); PG8_BAR; PG8_SCHED;
            PG8_LDA(At, 0, 1); PG8_STAGE(PG8_SB(0, 0), b2, voffB); PG8_STAGE(PG8_SB(0, 1), b2 + hstep, voffB); PG8_STAGE(PG8_SA(0, 0), a2, voffA);
            PG8_WAIT_V(8); PG8_WAIT_L(0); PG8_BAR; PG8_MMA(1, 0, At, B0); PG8_MMA(1, 1, At, B1); PG8_BAR; PG8_SCHED;
            PG8_LDB(B0, 1, 0); PG8_LDB(B1, 1, 1); PG8_SCHED; PG8_LDA(At, 1, 0); PG8_STAGE(PG8_SA(0, 1), a2 + hstep, voffA);
            PG8_WAIT_V(8); PG8_WAIT_L(0); PG8_BAR; PG8_MMA(0, 0, At, B0); PG8_MMA(0, 1, At, B1); PG8_BAR; PG8_SCHED;
            PG8_LDA(At, 1, 1); PG8_STAGE(PG8_SB(1, 0), b3, voffB); PG8_STAGE(PG8_SB(1, 1), b3 + hstep, voffB); PG8_STAGE(PG8_SA(1, 0), a3, voffA);
            PG8_WAIT_V(8); PG8_WAIT_L(0); PG8_BAR; PG8_MMA(1, 0, At, B0); PG8_MMA(1, 1, At, B1); PG8_BAR; PG8_SCHED;
            } else {
            PG8_LDB(B0, 0, 0); PG8_SCHED; PG8_LDA(At, 0, 0); PG8_STAGE(PG8_SA(1, 1), a1 + hstep, voffA);
            PG8_WAIT_L(8); PG8_BAR; PG8_WAIT_L(0); PG8_MMA(0, 0, At, B0); PG8_BAR; PG8_SCHED;
            PG8_LDB(B1, 0, 1); PG8_STAGE(PG8_SB(0, 0), b2, voffB);
            PG8_BAR; PG8_WAIT_L(0); PG8_MMA(0, 1, At, B1); PG8_BAR;
            PG8_LDA(At, 0, 1); PG8_STAGE(PG8_SA(0, 0), a2, voffA);
            PG8_BAR; PG8_WAIT_L(0); PG8_MMA(1, 0, At, B0); PG8_BAR; PG8_SCHED;
            PG8_STAGE(PG8_SB(0, 1), b2 + hstep, voffB);
            PG8_WAIT_V(6); PG8_BAR; PG8_MMA(1, 1, At, B1); PG8_BAR;
            PG8_LDB(B0, 1, 0); PG8_SCHED; PG8_LDA(At, 1, 0); PG8_STAGE(PG8_SA(0, 1), a2 + hstep, voffA);
            PG8_WAIT_L(8); PG8_BAR; PG8_WAIT_L(0); PG8_MMA(0, 0, At, B0); PG8_BAR; PG8_SCHED;
            PG8_LDB(B1, 1, 1); PG8_STAGE(PG8_SB(1, 0), b3, voffB);
            PG8_BAR; PG8_WAIT_L(0); PG8_MMA(0, 1, At, B1); PG8_BAR;
            PG8_LDA(At, 1, 1); PG8_STAGE(PG8_SA(1, 0), a3, voffA);
            PG8_BAR; PG8_WAIT_L(0); PG8_MMA(1, 0, At, B0); PG8_BAR; PG8_SCHED;
            PG8_STAGE(PG8_SB(1, 1), b3 + hstep, voffB);
            PG8_WAIT_V(6); PG8_BAR; PG8_MMA(1, 1, At, B1); PG8_BAR;
            }
        }
        if constexpr (ALIGN_EPI) { if (wr == 0) PG8_BAR; }
        if constexpr (!Epi::AFTER_DRAIN) { E(acc, cur, wr, wc, fr, fq); S.done(cur); }
        if (!has_next) break;
#pragma unroll
        for (int a = 0; a < 2; ++a)
#pragma unroll
            for (int b = 0; b < 2; ++b)
#pragma unroll
                for (int m = 0; m < 4; ++m)
#pragma unroll
                    for (int n = 0; n < 2; ++n) acc[a][b][m][n] = (f32x4){0.f, 0.f, 0.f, 0.f};
        cur = nxt; cA = nA; cB = nB; ++ui;
        if constexpr (ALIGN_EPI) { if (wr == 1) PG8_BAR; }
    }
    PG8_WAIT_V(0);
    if constexpr (!ALIGN_EPI) { if (wr == 0) PG8_BAR; }
    PG8_BAR;
#undef PG8_SA
#undef PG8_SB
#undef PG8_STAGE
#undef PG8_LDA
#undef PG8_LDB
#undef PG8_MMA
#undef PG8_WAIT_V
#undef PG8_WAIT_L
#undef PG8_BAR
#undef PG8_SCHED
}
template <class Epi>
__device__ __forceinline__ void gemm_tail(PG8_LAS unsigned char* lds, const Gemm g, const StaticOrder& S, const Epi& E) {
    int tid_ = threadIdx.x; asm volatile("" : "+v"(tid_));
    const int tid = tid_, wid = __builtin_amdgcn_readfirstlane(tid >> 6), lane = tid & 63, fr = lane & 15, fq = lane >> 4, wm = wid >> 1, wn = wid & 1;
    const int K = g.K, nt = K / 64, nleft = S.nwg - S.limit;
    constexpr int SLOT = 16384, NS = 8;
    for (int st = S.c; st < nleft * 16; st += S.G) {
        Unit u; S.unit_of(S.limit + (st >> 4), u); const int sub = st & 15;
        const int row0 = u.pm * BM + (sub >> 2) * 64, col0 = u.pn * BM + (sub & 3) * 64;
        const int pr = 8 * wid + (lane >> 3), pc = (lane & 7) ^ (pr & 7);
        const char* srcA = (const char*)(g.A + (size_t)(row0 + pr) * K) + pc * 16;
        const char* srcB = (const char*)(g.Bt + (size_t)(col0 + pr) * K) + pc * 16;
        const unsigned dA = (unsigned)wid * 1024u, dB = 8192u + (unsigned)wid * 1024u;
#define PG8_TSTAGE(kt) do { PG8_LAS unsigned char* sl_ = lds + ((kt) & (NS - 1)) * SLOT; \
            __builtin_amdgcn_global_load_lds((const unsigned*)(srcA + (size_t)(kt) * 128), (PG8_LAS unsigned*)(sl_ + dA), 16, 0, 0); \
            __builtin_amdgcn_global_load_lds((const unsigned*)(srcB + (size_t)(kt) * 128), (PG8_LAS unsigned*)(sl_ + dB), 16, 0, 0); } while (0)
        f32x4 acc[2];
        acc[0] = (f32x4){0.f, 0.f, 0.f, 0.f}; acc[1] = (f32x4){0.f, 0.f, 0.f, 0.f};
        const int ra = 16 * wm + fr, rb0 = 32 * wn + fr, rb1 = rb0 + 16;
#pragma unroll
        for (int kt = 0; kt < NS - 1; ++kt) PG8_TSTAGE(kt);
        for (int kt = 0; kt < nt; ++kt) {
            if (Epi::HAS_MID && kt == Epi::MID_T) E.tail_mid(acc, row0 + ra, col0 + 32 * wn + 4 * fq);
            const int newer = nt - 1 - kt;
            if (newer >= 6) asm volatile("s_waitcnt vmcnt(12)" ::: "memory");
            else if (newer == 5) asm volatile("s_waitcnt vmcnt(10)" ::: "memory");
            else if (newer == 4) asm volatile("s_waitcnt vmcnt(8)" ::: "memory");
            else if (newer == 3) asm volatile("s_waitcnt vmcnt(6)" ::: "memory");
            else if (newer == 2) asm volatile("s_waitcnt vmcnt(4)" ::: "memory");
            else if (newer == 1) asm volatile("s_waitcnt vmcnt(2)" ::: "memory");
            else asm volatile("s_waitcnt vmcnt(0)" ::: "memory");
            __builtin_amdgcn_s_barrier();
            if (kt + NS - 1 < nt) PG8_TSTAGE(kt + NS - 1);
            const PG8_LAS unsigned char* sl = lds + (kt & (NS - 1)) * SLOT;
            bf16x8 a[2], b0[2], b1[2];
#pragma unroll
            for (int h = 0; h < 2; ++h) { const int c = 4 * h + fq;
                a[h] = *(const PG8_LAS bf16x8*)(sl + ra * 128 + ((c ^ (ra & 7)) * 16));
                b0[h] = *(const PG8_LAS bf16x8*)(sl + 8192 + rb0 * 128 + ((c ^ (rb0 & 7)) * 16));
                b1[h] = *(const PG8_LAS bf16x8*)(sl + 8192 + rb1 * 128 + ((c ^ (rb1 & 7)) * 16)); }
#pragma unroll
            for (int h = 0; h < 2; ++h) { acc[0] = __builtin_amdgcn_mfma_f32_16x16x32_bf16(b0[h], a[h], acc[0], 0, 0, 0); acc[1] = __builtin_amdgcn_mfma_f32_16x16x32_bf16(b1[h], a[h], acc[1], 0, 0, 0); }
        }
        E.tail_out(acc, row0 + ra, col0 + 32 * wn + 4 * fq);
        asm volatile("s_waitcnt lgkmcnt(0)" ::: "memory"); __builtin_amdgcn_s_barrier();
#undef PG8_TSTAGE
    }
}
}

#define XB_TMO      128
#define XB_XCNT(j)  (256  + 64 * (j))
#define XB_XSUB(j)  (1280 + 64 * (j))
#define XB_XGEN(j)  (2304 + 64 * (j))
#define XB_TOP      3328
#define XB_TOPGEN   3392
#define XCD_BAR_WORDS 3456
#define XB_SPIN_CAP (1u << 18)
__device__ __forceinline__ unsigned xb_ld(unsigned* p)              { return __hip_atomic_load(p, __ATOMIC_RELAXED, __HIP_MEMORY_SCOPE_AGENT); }
__device__ __forceinline__ unsigned xb_add(unsigned* p, unsigned v) { return __hip_atomic_fetch_add(p, v, __ATOMIC_RELAXED, __HIP_MEMORY_SCOPE_AGENT); }
__device__ __forceinline__ unsigned xb_xcc_id() { return (unsigned)__builtin_amdgcn_s_getreg((3 << 11) | 20) & 0xFu; }
#define XB_SPIN(cond, bar) do { unsigned _sp = 0; while (cond) { __builtin_amdgcn_s_sleep(1); \
    if ((++_sp & 255u) == 0u) { if (xb_ld(&(bar)[XB_TMO])) break; if (_sp > XB_SPIN_CAP) { atomicAdd(&(bar)[XB_TMO], 1u); break; } } } } while (0)
struct XcdBarrier { unsigned* bar; unsigned x; volatile LAS unsigned* st; };
__device__ __forceinline__ XcdBarrier xcd_barrier_post(unsigned* bar, volatile LAS unsigned* st) {
    XcdBarrier b; b.bar = bar; b.x = xb_xcc_id(); b.st = st;
    if (threadIdx.x == 0) (void)xb_add(&bar[XB_XCNT(b.x)], 1u);
    return b;
}
__device__ __forceinline__ void xcd_barrier_complete(unsigned* bar, unsigned x, unsigned& nloc, unsigned& nx) {
    const unsigned G = gridDim.x * gridDim.y * gridDim.z;
    unsigned sum, cnt, mine, sp = 0u;
    for (;;) {
        sum = 0u; cnt = 0u; mine = 0u;
#pragma unroll
        for (unsigned j = 0; j < 16; ++j) { const unsigned c = xb_ld(&bar[XB_XCNT(j)]); sum += c; cnt += (c > 0u) ? 1u : 0u; mine = (j == x) ? c : mine; }
        if (sum == G) break;
        __builtin_amdgcn_s_sleep(1);
        if ((++sp & 255u) == 0u) { if (xb_ld(&bar[XB_TMO])) break; if (sp > XB_SPIN_CAP) { atomicAdd(&bar[XB_TMO], 1u); break; } }
    }
    nloc = mine > 0u ? mine : 1u; nx = cnt > 0u ? cnt : 1u;
}
__device__ __forceinline__ void xcd_barrier(const XcdBarrier& b) {
    asm volatile("s_waitcnt vmcnt(0)" ::: "memory");
    __syncthreads();
    if (threadIdx.x == 0) {
        unsigned* bar = b.bar;
        __builtin_amdgcn_s_waitcnt(0);
        unsigned nloc = b.st[0], nx = b.st[1];
        if (nloc == 0u) { xcd_barrier_complete(bar, b.x, nloc, nx); b.st[0] = nloc; b.st[1] = nx; }
        const unsigned old = xb_add(&bar[XB_XSUB(b.x)], 1u);
        const unsigned gen = old / nloc;
        if (old + 1u == (gen + 1u) * nloc) {
            __builtin_amdgcn_fence(__ATOMIC_RELEASE, "agent");
            asm volatile("s_waitcnt vmcnt(0)" ::: "memory");
            const unsigned og = xb_add(&bar[XB_TOP], 1u);
            const unsigned tg = og / nx;
            if (og + 1u == (tg + 1u) * nx) xb_add(&bar[XB_TOPGEN], 1u);
            else XB_SPIN(xb_ld(&bar[XB_TOPGEN]) == tg, bar);
            __builtin_amdgcn_fence(__ATOMIC_ACQUIRE, "agent");
            xb_add(&bar[XB_XGEN(b.x)], 1u);
            asm volatile("s_waitcnt vmcnt(0)" ::: "memory");
        } else {
            XB_SPIN(xb_ld(&bar[XB_XGEN(b.x)]) == gen, bar);
            __builtin_amdgcn_fence(__ATOMIC_ACQUIRE, "agent");
            asm volatile("s_waitcnt vmcnt(0)" ::: "memory");
        }
    }
    __syncthreads();
}

struct Frame {
    LAS unsigned char* lds;
    volatile LAS unsigned* MISC;
    gu32* ctl;
    int tid, lane, wave, vcu, G, mode;
    const float *xp, *xs, *ck, *cv, *sconv, *npre, *npost, *w_in, *lq1, *lk1, *lq2, *lk2, *hnorm, *convw, *wpa, *wpc, *wout, *relb;
    float* out;
    unsigned char* ws;
    __device__ __forceinline__ bf16_t* W1T() const { return (bf16_t*)(ws + WS_W1T); }
    __device__ __forceinline__ bf16_t* W3T() const { return (bf16_t*)(ws + WS_W3T); }
    __device__ __forceinline__ bf16_t* W4T() const { return (bf16_t*)(ws + WS_W4T); }
    __device__ __forceinline__ bf16_t* XN() const { return (bf16_t*)(ws + WS_XN); }
    __device__ __forceinline__ bf16_t* QB() const { return (bf16_t*)(ws + WS_QB); }
    __device__ __forceinline__ bf16_t* KB() const { return (bf16_t*)(ws + WS_KB); }
    __device__ __forceinline__ bf16_t* VB() const { return (bf16_t*)(ws + WS_VB); }
    __device__ __forceinline__ bf16_t* A3() const { return (bf16_t*)(ws + WS_A3); }
    __device__ __forceinline__ bf16_t* U() const { return (bf16_t*)(ws + WS_U); }
    __device__ __forceinline__ bf16_t* RB() const { return (bf16_t*)(ws + WS_RB); }
    __device__ __forceinline__ bf16_t* S2() const { return (bf16_t*)(ws + WS_S2); }
    __device__ __forceinline__ bf16_t* MB() const { return (bf16_t*)(ws + WS_MB); }
    __device__ __forceinline__ bf16_t* Y() const { return (bf16_t*)(ws + WS_Y); }
};
__device__ __forceinline__ float wave_sum(float v) {
#pragma unroll
    for (int o = 1; o < 64; o <<= 1) v += __shfl_xor(v, o);
    return v;
}

template <class ColMap>
__device__ __forceinline__ void p0_tr_item(const float* W, int ldw, bf16_t* WT, int ldt, int koff, int k0, int n0, const ColMap& cm, LAS float* scr, int lane) {
    const int sc = cm(n0 + (lane & 31));
#pragma unroll 8
    for (int i = 0; i < 32; ++i) { const int kk = 2 * i + (lane >> 5); scr[kk * 33 + (lane & 31)] = W[(size_t)(k0 + kk) * ldw + sc]; }
    LDS_WAIT(); asm volatile("" ::: "memory");
    const int c = lane & 7;
#pragma unroll
    for (int j = 0; j < 4; ++j) { const int n = (lane >> 3) + 8 * j; const LAS float* s = scr + (8 * c) * 33 + n;
        u32x4 o; o.x = pk_bf16(s[0 * 33], s[1 * 33]); o.y = pk_bf16(s[2 * 33], s[3 * 33]); o.z = pk_bf16(s[4 * 33], s[5 * 33]); o.w = pk_bf16(s[6 * 33], s[7 * 33]);
        *(GAS u32x4*)(WT + (size_t)(n0 + n) * ldt + koff + k0 + 8 * c) = o; }
    LDS_WAIT(); asm volatile("" ::: "memory");
}
struct CmId { __device__ __forceinline__ int operator()(int n) const { return n; } };
struct CmW1 { __device__ __forceinline__ int operator()(int n) const { return orig_col(n); } };
__device__ __forceinline__ void rms_row_to_bf16(const float* xrow, const float* g, bf16_t* orow, int lane) {
    const GAS f32x4* xr = (const GAS f32x4*)xrow + lane; const GAS f32x4* gr = (const GAS f32x4*)g + lane;
    f32x4 v[8]; float s = 0.f;
#pragma unroll
    for (int j = 0; j < 8; ++j) { v[j] = xr[64 * j]; s += (v[j].x * v[j].x + v[j].y * v[j].y) + (v[j].z * v[j].z + v[j].w * v[j].w); }
    const float rs = 1.f / sqrtf(wave_sum(s) * (1.f / D_MODEL) + EPS);
    GAS u32x2* o8 = (GAS u32x2*)orow + lane;
#pragma unroll
    for (int j = 0; j < 8; ++j) { const f32x4 gg = gr[64 * j]; u32x2 w; w.x = pk_bf16(v[j].x * rs * gg.x, v[j].y * rs * gg.y); w.y = pk_bf16(v[j].z * rs * gg.z, v[j].w * rs * gg.w); o8[64 * j] = w; }
}
__device__ __forceinline__ void p0_prologue(Frame& F) {
    LAS float* scr = (LAS float*)(F.lds + F.wave * 16384);
    const int gw = F.vcu * NWAVES + F.wave, NGW = F.G * NWAVES;
    constexpr int I_1 = (D_MODEL / 64) * (N_IN / 32), I_3 = (1024 / 64) * (D_MODEL / 32), I_4 = (D_MODEL / 64) * (D_MODEL / 32);
    constexpr int NITEMS = I_1 + 2 * I_3 + I_4;
    for (int it = gw; it < NITEMS; it += NGW) {
        int r = it;
        if (r < I_1) { const int nblk = N_IN / 32, kb = r / nblk, nb = r % nblk; p0_tr_item(F.w_in, N_IN, F.W1T(), D_MODEL, 0, 64 * kb, 32 * nb, CmW1{}, scr, F.lane); continue; } r -= I_1;
        if (r < I_3) { const int nblk = D_MODEL / 32, kb = r / nblk, nb = r % nblk; p0_tr_item(F.wpa, D_MODEL, F.W3T(), 2048, 0, 64 * kb, 32 * nb, CmId{}, scr, F.lane); continue; } r -= I_3;
        if (r < I_3) { const int nblk = D_MODEL / 32, kb = r / nblk, nb = r % nblk; p0_tr_item(F.wpc, D_MODEL, F.W3T(), 2048, 1024, 64 * kb, 32 * nb, CmId{}, scr, F.lane); continue; } r -= I_3;
        { const int nblk = D_MODEL / 32, kb = r / nblk, nb = r % nblk; p0_tr_item(F.wout, D_MODEL, F.W4T(), 2048, 0, 64 * kb, 32 * nb, CmId{}, scr, F.lane); }
    }
    for (int m = gw; m < M; m += NGW) { const float* xr = (m < MP) ? F.xp + (size_t)m * D_MODEL : F.xs + (size_t)(m - MP) * D_MODEL; rms_row_to_bf16(xr, F.npre, F.XN() + (size_t)m * D_MODEL, F.lane); }
}

namespace att {
constexpr int L_K = 0, L_V = 32768, L_STG = 65536, TILEB = 16384;
constexpr float THR = 8.f;
__device__ __forceinline__ int off_b(int row, int ch) { return 256 * row + 16 * (ch ^ (((row & 3) << 2) | ((row >> 2) & 3))); }
__device__ __forceinline__ int crow(int r, int hi) { return (r & 3) + 8 * (r >> 2) + 4 * hi; }
typedef short v4i16_t __attribute__((ext_vector_type(4)));
__device__ __forceinline__ s16x4 vtr(LAS const unsigned char* p) { return __builtin_bit_cast(s16x4, __builtin_amdgcn_ds_read_tr16_b64_v4i16((LAS v4i16_t*)p)); }
#define MFMA32(a, b, c) __builtin_amdgcn_mfma_f32_32x32x16_bf16((a), (b), (c), 0, 0, 0)
__device__ __forceinline__ int rel_bucket(int rel) {
    const int ret = rel > 0 ? 16 : 0, n = rel < 0 ? -rel : rel;
    if (n < 8) return ret + n;
    int large = 8 + (31 - __clz(n * n)) - 6; large = large > 15 ? 15 : large;
    return ret + large;
}
__device__ __forceinline__ void qk_map(f32x16& p0, f32x16& p1, LAS const unsigned char* kbuf, LAS const unsigned char* qbuf, int map, const f32x16& cinit, int r32, int hi) {
    const int xr = ((r32 & 3) << 2) | ((r32 >> 2) & 3), rb = 256 * r32;
#pragma unroll
    for (int s = 0; s < 4; ++s) {
        const int o = rb + 16 * ((map * 8 + 2 * s + hi) ^ xr);
        const bf16x8 qf = *(LAS const bf16x8*)(qbuf + o);
        const bf16x8 a0 = *(LAS const bf16x8*)(kbuf + o), a1 = *(LAS const bf16x8*)(kbuf + o + 8192);
        if (s == 0) { p0 = MFMA32(a0, qf, cinit); p1 = MFMA32(a1, qf, cinit); } else { p0 = MFMA32(a0, qf, p0); p1 = MFMA32(a1, qf, p1); }
    }
}
__device__ __forceinline__ float rowmax32(const f32x16& p0, const f32x16& p1) {
    float a = __builtin_fmaxf(p0[0], p1[0]);
#pragma unroll
    for (int r = 1; r < 16; ++r) a = __builtin_fmaxf(__builtin_fmaxf(a, p0[r]), p1[r]);
    return __builtin_fmaxf(a, __shfl_xor(a, 32));
}
template <int NB, bool PIPE = false>
__device__ __forceinline__ void softmax_tile(f32x16& p0, f32x16& p1, float& m, float& l, f32x16 (&o)[NB], f32x16& negm, float c15, bool first, f32x16* pn0 = nullptr, f32x16* pn1 = nullptr) {
    if (first) { const float rm = rowmax32(p0, p1); m = rm;
#pragma unroll
        for (int r = 0; r < 16; ++r) { p0[r] -= rm; p1[r] -= rm; negm[r] = c15 - rm; if (PIPE) { (*pn0)[r] -= rm; (*pn1)[r] -= rm; } } }
    f32x16 e0, e1; float s = 0.f;
#pragma unroll
    for (int r = 0; r < 16; ++r) { e0[r] = fast_exp2(p0[r]); e1[r] = fast_exp2(p1[r]); s += e0[r] + e1[r]; }
    if (__builtin_expect(__any(!(s <= 4096.f)), 0)) {
        const float rm = rowmax32(p0, p1), dl = fmaxf(rm, 0.f); m += dl;
        const float f = fast_exp2(-dl); l *= f; s = 0.f;
#pragma unroll
        for (int r = 0; r < 16; ++r) { e0[r] = fast_exp2(p0[r] - dl); e1[r] = fast_exp2(p1[r] - dl); s += e0[r] + e1[r]; negm[r] = c15 - m; if (PIPE) { (*pn0)[r] -= dl; (*pn1)[r] -= dl; } }
#pragma unroll
        for (int i = 0; i < NB; ++i)
#pragma unroll
            for (int r = 0; r < 16; ++r) o[i][r] *= f;
    }
    l += s; p0 = e0; p1 = e1;
}
__device__ __forceinline__ bf16x8 pack8(const f32x16& p, int s) {
    u32x4 w; w.x = pk_bf16(p[8 * s], p[8 * s + 1]); w.y = pk_bf16(p[8 * s + 2], p[8 * s + 3]); w.z = pk_bf16(p[8 * s + 4], p[8 * s + 5]); w.w = pk_bf16(p[8 * s + 6], p[8 * s + 7]);
    return __builtin_bit_cast(bf16x8, w);
}
__device__ __forceinline__ void add_bias(f32x16& p0, f32x16& p1, LAS const float* tab, int idx0) {
#pragma unroll
    for (int r = 0; r < 16; ++r) { const int o = idx0 + (r & 3) + 8 * (r >> 2); p0[r] += tab[o]; p1[r] += tab[o + 32]; }
}
__device__ __forceinline__ bf16x8 vfrag(LAS const unsigned char* vbuf, int c, int half, int s, int lane) {
    const int hi = lane >> 5, blk = (lane >> 4) & 1, qp = (lane & 15) >> 2, p = lane & 3;
    const int lo = 256 * qp + 8 * (p & 1) + 16 * (4 * (c ^ qp));
    const int R0 = 32 * half + 16 * s + 4 * hi;
    const int a0 = lo + 256 * R0 + 16 * ((2 * blk + (p >> 1)) ^ hi), a1 = lo + 256 * (R0 + 8) + 16 * ((2 * blk + (p >> 1)) ^ (2 + hi));
    const s16x4 x = vtr(vbuf + a0), y = vtr(vbuf + a1);
    return (bf16x8){x[0], x[1], x[2], x[3], y[0], y[1], y[2], y[3]};
}
struct TileRegs { u32x4 k0, k1, v0, v1; };
__device__ __forceinline__ void load_tile_bf16(TileRegs& R, const bf16_t* Kb, const bf16_t* Vb, size_t row0, int h, int tid, int nvalid) {
    const int row = tid >> 3, c = tid & 7;
    if (row < nvalid) { const u32x4* kp = (const u32x4*)(Kb + (row0 + row) * 1024 + h * 128); const u32x4* vp = (const u32x4*)(Vb + (row0 + row) * 1024 + h * 128);
        R.k0 = kp[c]; R.k1 = kp[c + 8]; R.v0 = vp[c]; R.v1 = vp[c + 8]; }
    else { R.k0 = R.k1 = R.v0 = R.v1 = (u32x4){0u, 0u, 0u, 0u}; }
}
__device__ __forceinline__ void store_tile_bf16(const TileRegs& R, LAS unsigned char* kbuf, LAS unsigned char* vbuf, int tid) {
    const int row = tid >> 3, c = tid & 7;
    *(LAS u32x4*)(kbuf + off_b(row, c)) = R.k0; *(LAS u32x4*)(kbuf + off_b(row, c + 8)) = R.k1;
    *(LAS u32x4*)(vbuf + off_b(row, c)) = R.v0; *(LAS u32x4*)(vbuf + off_b(row, c + 8)) = R.v1;
}
__device__ __forceinline__ void load_half_bf16(u32x4& r0, u32x4& r1, const bf16_t* B, size_t row0, int h, int tid) { const int row = tid >> 3, c = tid & 7; const u32x4* p = (const u32x4*)(B + (row0 + row) * 1024 + h * 128); r0 = p[c]; r1 = p[c + 8]; }
__device__ __forceinline__ void store_half_bf16(const u32x4& r0, const u32x4& r1, LAS unsigned char* buf, int tid) { const int row = tid >> 3, c = tid & 7; *(LAS u32x4*)(buf + off_b(row, c)) = r0; *(LAS u32x4*)(buf + off_b(row, c + 8)) = r1; }
struct TileRegsF { f32x4 k[4], v[4]; };
__device__ __forceinline__ void load_tile_f32(TileRegsF& R, const float* ck, const float* cv, int key0, int h, int tid) {
    const int pc = tid & 31;
#pragma unroll
    for (int i = 0; i < 4; ++i) { const int row = (tid >> 5) + 16 * i; const size_t o = ((size_t)(key0 + row) * NH + h) * 128 + pc * 4;
        R.k[i] = __builtin_nontemporal_load((const f32x4*)(ck + o)); R.v[i] = __builtin_nontemporal_load((const f32x4*)(cv + o)); }
}
__device__ __forceinline__ void store_tile_f32(const TileRegsF& R, LAS unsigned char* kbuf, LAS unsigned char* vbuf, int tid) {
    const int pc = tid & 31;
#pragma unroll
    for (int i = 0; i < 4; ++i) { const int row = (tid >> 5) + 16 * i; const int o = off_b(row, pc >> 1) + 8 * (pc & 1);
        u32x2 a; a.x = pk_bf16(R.k[i].x, R.k[i].y); a.y = pk_bf16(R.k[i].z, R.k[i].w); *(LAS u32x2*)(kbuf + o) = a;
        u32x2 b; b.x = pk_bf16(R.v[i].x, R.v[i].y); b.y = pk_bf16(R.v[i].z, R.v[i].w); *(LAS u32x2*)(vbuf + o) = b; }
}
__device__ __forceinline__ void stage_q(LAS unsigned char* qbuf, const bf16_t* Qb, size_t row0, int nrows, int h, int lane) {
#pragma unroll
    for (int i = 0; i < 8; ++i) { const int row = (lane >> 4) + 4 * i, ch = lane & 15; const int rr = row < nrows ? row : row % nrows;
        *(LAS u32x4*)(qbuf + off_b(row, ch)) = *(const u32x4*)(Qb + (row0 + rr) * 1024 + h * 128 + ch * 8); }
}

__device__ __forceinline__ void prompt_unit(Frame& F, int b, int h, int qb, float lam) {
    int tid_ = F.tid; asm volatile("" : "+v"(tid_));
    const int tid = tid_, lane = tid_ & 63, wid = F.wave, map = wid >> 2, qblk = wid & 3;
    LAS unsigned char* lds = F.lds; LAS float* tab = (LAS float*)(lds + TAB_OFF); LAS const float* hn = (LAS const float*)(lds + HN_OFF);
    LAS unsigned char* qbuf = lds + L_STG + wid * 8192;
    const float c15 = F.relb[15 * NH + h] * LOG2E;
    if (tid < 256) tab[tid] = F.relb[rel_bucket(tid - 192) * NH + h] * LOG2E - c15;
    const int q0w = 128 * qb + 32 * qblk, cw = 2 * qb + (qblk >> 1), NT = 2 * qb + 2;
    const size_t rowb = (size_t)b * SEQ;
    stage_q(qbuf, F.QB(), rowb + q0w, 32, h, lane);
    TileRegs R;
    load_half_bf16(R.k0, R.k1, F.KB(), rowb, h, tid); load_half_bf16(R.v0, R.v1, F.VB(), rowb, h, tid);
    store_half_bf16(R.k0, R.k1, lds + L_K, tid); store_half_bf16(R.v0, R.v1, lds + L_V, tid);
    load_half_bf16(R.k0, R.k1, F.KB(), rowb + 64, h, tid); store_half_bf16(R.k0, R.k1, lds + L_K + TILEB, tid);
    __syncthreads();
    float m = 0.f, l = 0.f; f32x16 o[4], negm;
#pragma unroll
    for (int c = 0; c < 4; ++c)
#pragma unroll
        for (int r = 0; r < 16; ++r) o[c][r] = 0.f;
#pragma unroll
    for (int r = 0; r < 16; ++r) negm[r] = c15;
    const int r32 = lane & 31, hi = lane >> 5;
    f32x16 pa0, pa1, pb0, pb1;
    qk_map(pa0, pa1, lds + L_K, qbuf, map, negm, r32, hi);
    if (-q0w > -154) add_bias(pa0, pa1, tab, -(q0w + r32) + 192 + 4 * hi);
    { const float rm = rowmax32(pa0, pa1); m = rm;
#pragma unroll
      for (int r = 0; r < 16; ++r) { pa0[r] -= rm; pa1[r] -= rm; negm[r] = c15 - rm; } }
#define PROMPT_STEP(t, P0, P1, N0, N1) do { \
        int tidl = tid; asm volatile("" : "+v"(tidl)); \
        if ((t) + 2 < NT) load_half_bf16(R.k0, R.k1, F.KB(), rowb + (size_t)((t) + 2) * 64, h, tidl); \
        if ((t) + 1 < NT) load_half_bf16(R.v0, R.v1, F.VB(), rowb + (size_t)((t) + 1) * 64, h, tidl); \
        if ((t) <= cw) { \
            LAS const unsigned char* vbuf = lds + L_V + ((t) & 1) * TILEB; \
            qk_map(N0, N1, lds + L_K + (((t) + 1) & 1) * TILEB, qbuf, map, negm, r32, hi);        \
            float s_ = 0.f; \
            _Pragma("unroll") for (int r = 0; r < 16; ++r) { P0[r] = fast_exp2(P0[r]); P1[r] = fast_exp2(P1[r]); } \
            _Pragma("unroll") for (int r = 0; r < 16; ++r) s_ += P0[r] + P1[r]; \
            __builtin_amdgcn_sched_group_barrier(0x100, 12, 0); \
            _Pragma("unroll") for (int i_ = 0; i_ < 8; ++i_) { __builtin_amdgcn_sched_group_barrier(0x8, 1, 0); __builtin_amdgcn_sched_group_barrier(0x400, 4, 0); } \
            if (__builtin_expect(__any(!(s_ <= 4096.f)), 0)) {          \
                qk_map(P0, P1, lds + L_K + ((t) & 1) * TILEB, qbuf, map, negm, r32, hi);          \
                if (64 * (t) - q0w > -154) add_bias(P0, P1, tab, 64 * (t) - (q0w + r32) + 192 + 4 * hi); \
                const float rm = rowmax32(P0, P1), dl = fmaxf(rm, 0.f); m += dl; \
                const float f = fast_exp2(-dl); l *= f; s_ = 0.f; \
                _Pragma("unroll") for (int r = 0; r < 16; ++r) { P0[r] = fast_exp2(P0[r] - dl); P1[r] = fast_exp2(P1[r] - dl); s_ += P0[r] + P1[r]; negm[r] = c15 - m; N0[r] -= dl; N1[r] -= dl; } \
                _Pragma("unroll") for (int c = 0; c < 4; ++c) _Pragma("unroll") for (int r = 0; r < 16; ++r) o[c][r] *= f; \
            } \
            l += s_; \
            if (64 * ((t) + 1) - q0w > -154) add_bias(N0, N1, tab, 64 * ((t) + 1) - (q0w + r32) + 192 + 4 * hi); \
            bf16x8 pf[2][2]; pf[0][0] = pack8(P0, 0); pf[0][1] = pack8(P0, 1); pf[1][0] = pack8(P1, 0); pf[1][1] = pack8(P1, 1); \
            _Pragma("unroll") for (int c = 0; c < 4; ++c) _Pragma("unroll") for (int half = 0; half < 2; ++half) _Pragma("unroll") for (int s = 0; s < 2; ++s) \
                o[c] = MFMA32(vfrag(vbuf, c, half, s, lane), pf[half][s], o[c]); \
        } \
        if ((t) + 2 < NT) store_half_bf16(R.k0, R.k1, lds + L_K + ((t) & 1) * TILEB, tidl); \
        if ((t) + 1 < NT) store_half_bf16(R.v0, R.v1, lds + L_V + (((t) + 1) & 1) * TILEB, tidl); \
        __syncthreads(); } while (0)
    for (int t = 0; t < NT; t += 2) {
        PROMPT_STEP(t, pa0, pa1, pb0, pb1);
        PROMPT_STEP(t + 1, pb0, pb1, pa0, pa1);
    }
#undef PROMPT_STEP
    int lane2 = lane; asm volatile("" : "+v"(lane2));
    const int r32e = lane2 & 31, hie = lane2 >> 5;
    l += __shfl_xor(l, 32);
    LAS float* xch = (LAS float*)(lds + L_STG + qblk * 16384);
    if (map == 1) { const float i2 = lam / l;
#pragma unroll
        for (int c = 0; c < 4; ++c)
#pragma unroll
            for (int r = 0; r < 16; ++r) xch[(c * 16 + r) * 64 + lane2] = o[c][r] * i2; }
    __syncthreads();
    if (map == 0) {
        const float i1 = 1.f / l; float ssq = 0.f;
#pragma unroll
        for (int c = 0; c < 4; ++c)
#pragma unroll
            for (int r = 0; r < 16; ++r) { const float v = o[c][r] * i1 - xch[(c * 16 + r) * 64 + lane2]; o[c][r] = v; ssq += v * v; }
        ssq += __shfl_xor(ssq, 32);
        const float rs = 1.f / sqrtf(ssq * (1.f / DV) + EPS);
        LAS unsigned char* ob = (LAS unsigned char*)xch;
#pragma unroll
        for (int c = 0; c < 4; ++c)
#pragma unroll
            for (int g = 0; g < 4; ++g) { const int d = 32 * c + 8 * g + 4 * hie; const f32x4 hv = *(LAS const f32x4*)(hn + d);
                u32x2 w; w.x = pk_bf16(o[c][4 * g] * rs * hv.x, o[c][4 * g + 1] * rs * hv.y); w.y = pk_bf16(o[c][4 * g + 2] * rs * hv.z, o[c][4 * g + 3] * rs * hv.w);
                *(LAS u32x2*)(ob + r32e * 256 + (((4 * c + g) ^ (r32e & 7)) * 16) + hie * 8) = w; }
#pragma unroll
        for (int i = 0; i < 8; ++i) { const int row = 4 * i + (lane2 >> 4), c16 = lane2 & 15;
            const u32x4 v = *(LAS const u32x4*)(ob + row * 256 + ((c16 ^ (row & 7)) * 16));
            bf16_t* ap = F.A3() + (rowb + q0w + row) * 2048 + h * 128 + c16 * 8; const u32x4 z = *(const u32x4*)ap;
            u32x4 w; w.x = pk_bf16(bf_lo(v.x) * bf_lo(z.x), bf_hi(v.x) * bf_hi(z.x)); w.y = pk_bf16(bf_lo(v.y) * bf_lo(z.y), bf_hi(v.y) * bf_hi(z.y));
            w.z = pk_bf16(bf_lo(v.z) * bf_lo(z.z), bf_hi(v.z) * bf_hi(z.z)); w.w = pk_bf16(bf_lo(v.w) * bf_lo(z.w), bf_hi(v.w) * bf_hi(z.w));
            *(u32x4*)ap = w; }
    }
    __syncthreads();
}

__device__ __forceinline__ void sample_unit(Frame& F, int b, int h, float lam) {
    int tid_ = F.tid; asm volatile("" : "+v"(tid_));
    const int tid = tid_, lane = tid_ & 63, wid = F.wave, r32 = lane & 31, hi = lane >> 5, map = wid >> 2, c = wid & 3;
    LAS unsigned char* lds = F.lds; LAS float* tab = (LAS float*)(lds + TAB_OFF); LAS const float* hn = (LAS const float*)(lds + HN_OFF);
    LAS unsigned char* qbuf = lds + L_STG + wid * 8192;
    const float c15 = F.relb[15 * NH + h] * LOG2E;
    if (tid < 256) tab[tid] = F.relb[rel_bucket(tid - 192) * NH + h] * LOG2E - c15;
    const size_t rowq = (size_t)MP + (size_t)b * DEC_SEQ;
    stage_q(qbuf, F.QB(), rowq, 16, h, lane);
    const float* ck = F.ck + (size_t)b * PAST * NH * 128; const float* cv = F.cv + (size_t)b * PAST * NH * 128;
    constexpr int NTC = PAST / 64;
    float m = 0.f, l = 0.f; f32x16 o[1], negm;
#pragma unroll
    for (int r = 0; r < 16; ++r) { o[0][r] = 0.f; negm[r] = c15; }
#define SAMPLE_TILE(t) do { \
        int lane_ = lane; asm volatile("" : "+v"(lane_)); \
        const int r32_ = lane_ & 31, hi_ = lane_ >> 5, qi_ = r32_ & 15; \
        LAS const unsigned char* kbuf = lds + L_K + ((t) & 1) * TILEB; LAS const unsigned char* vbuf = lds + L_V + ((t) & 1) * TILEB; \
        const bool near = ((t) >= 30), first = ((t) == 0); \
        f32x16 p0, p1; \
        qk_map(p0, p1, kbuf, qbuf, map, negm, r32_, hi_); \
        if (near) add_bias(p0, p1, tab, 64 * (t) - (PAST + qi_) + 192 + 4 * hi_); \
        if ((t) == NTC) { _Pragma("unroll") for (int r = 0; r < 16; ++r) { if (crow(r, hi_) >= DEC_SEQ) p0[r] = -__builtin_inff(); p1[r] = -__builtin_inff(); } } \
        softmax_tile<1>(p0, p1, m, l, o, negm, c15, first); \
        const bf16x8 pf00 = pack8(p0, 0), pf01 = pack8(p0, 1), pf10 = pack8(p1, 0), pf11 = pack8(p1, 1); \
        o[0] = MFMA32(vfrag(vbuf, c, 0, 0, lane_), pf00, o[0]); o[0] = MFMA32(vfrag(vbuf, c, 0, 1, lane_), pf01, o[0]); \
        o[0] = MFMA32(vfrag(vbuf, c, 1, 0, lane_), pf10, o[0]); o[0] = MFMA32(vfrag(vbuf, c, 1, 1, lane_), pf11, o[0]); } while (0)
    TileRegsF R0, R1;
    load_tile_f32(R0, ck, cv, 0, h, tid); load_tile_f32(R1, ck, cv, 64, h, tid);
    store_tile_f32(R0, lds + L_K, lds + L_V, tid); load_tile_f32(R0, ck, cv, 128, h, tid);
    __syncthreads();
    for (int t = 0; t < NTC; t += 2) {
        SAMPLE_TILE(t);
        store_tile_f32(R1, lds + L_K + TILEB, lds + L_V + TILEB, tid);
        if (t + 3 < NTC) load_tile_f32(R1, ck, cv, (t + 3) * 64, h, tid);
        __syncthreads();
        SAMPLE_TILE(t + 1);
        if (t + 2 < NTC) { store_tile_f32(R0, lds + L_K, lds + L_V, tid); if (t + 4 < NTC) load_tile_f32(R0, ck, cv, (t + 4) * 64, h, tid); }
        else { TileRegs RN; load_tile_bf16(RN, F.KB(), F.VB(), rowq, h, tid, DEC_SEQ); store_tile_bf16(RN, lds + L_K, lds + L_V, tid); }
        __syncthreads();
    }
    SAMPLE_TILE(NTC);
    __syncthreads();
#undef SAMPLE_TILE
    l += __shfl_xor(l, 32);
    const float inv = 1.f / l;
    LAS float* stg = (LAS float*)(lds + L_K);
    if (r32 < 16) {
#pragma unroll
        for (int g = 0; g < 4; ++g) { const f32x4 v = {o[0][4 * g] * inv, o[0][4 * g + 1] * inv, o[0][4 * g + 2] * inv, o[0][4 * g + 3] * inv};
            *(LAS f32x4*)(stg + (map * 16 + r32) * 128 + 32 * c + 8 * g + 4 * hi) = v; }
    }
    __syncthreads();
    {
        const int q = tid >> 5, d4 = (tid & 31) * 4;
        const f32x4 s1 = *(LAS const f32x4*)(stg + q * 128 + d4), s2 = *(LAS const f32x4*)(stg + (16 + q) * 128 + d4);
        f32x4 v = s1 - s2 * lam; float ssq = (v.x * v.x + v.y * v.y) + (v.z * v.z + v.w * v.w);
#pragma unroll
        for (int x = 1; x < 32; x <<= 1) ssq += __shfl_xor(ssq, x);
        const float rs = 1.f / sqrtf(ssq * (1.f / DV) + EPS); const f32x4 hv = *(LAS const f32x4*)(hn + d4);
        bf16_t* ap = F.A3() + (rowq + q) * 2048 + h * 128 + d4; const u32x2 z = *(const u32x2*)ap;
        u32x2 w; w.x = pk_bf16(v.x * rs * hv.x * bf_lo(z.x), v.y * rs * hv.y * bf_hi(z.x)); w.y = pk_bf16(v.z * rs * hv.z * bf_lo(z.y), v.w * rs * hv.w * bf_hi(z.y));
        *(u32x2*)ap = w;
    }
    __syncthreads();
}
#undef MFMA32
}

__device__ __forceinline__ void unpack8(const u32x4 w, float (&f)[8]) { f[0] = bf_lo(w.x); f[1] = bf_hi(w.x); f[2] = bf_lo(w.y); f[3] = bf_hi(w.y); f[4] = bf_lo(w.z); f[5] = bf_hi(w.z); f[6] = bf_lo(w.w); f[7] = bf_hi(w.w); }
__device__ __forceinline__ void conv_phase(Frame& F, int widx, int nwg) {
    const int NTH = nwg * NWAVES * 64; const int gt = widx * (NWAVES * 64) + F.tid;
    const bf16_t* U = F.U(); bf16_t* A3 = F.A3();
    for (int it = gt; it < (M / 8) * 128; it += NTH) {
        const int row0 = (it >> 7) * 8, c8 = (it & 127) * 8;
        int t0, T; const float* st = nullptr; float* oc;
        if (row0 < MP) { t0 = row0 & (SEQ - 1); T = SEQ; oc = F.out + O_CP + (size_t)(row0 >> 11) * 2 * CONV_W; }
        else { const int sr = row0 - MP; t0 = sr & (DEC_SEQ - 1); T = DEC_SEQ; st = F.sconv + (size_t)(sr >> 4) * 2 * CONV_W; oc = F.out + O_CS + (size_t)(sr >> 4) * 2 * CONV_W; }
        u32x4 uw[10], gw[8];
#pragma unroll
        for (int i = 0; i < 8; ++i) { uw[i + 2] = *(const u32x4*)(U + (size_t)(row0 + i) * 1024 + c8); gw[i] = *(const u32x4*)(A3 + (size_t)(row0 + i) * 2048 + 1024 + c8); }
        float um2[8], um1[8];
        if (t0 >= 2) { uw[0] = *(const u32x4*)(U + (size_t)(row0 - 2) * 1024 + c8); uw[1] = *(const u32x4*)(U + (size_t)(row0 - 1) * 1024 + c8); unpack8(uw[0], um2); unpack8(uw[1], um1); }
        else if (st) { const f32x4 a = *(const f32x4*)(st + c8), b = *(const f32x4*)(st + c8 + 4), c = *(const f32x4*)(st + CONV_W + c8), d = *(const f32x4*)(st + CONV_W + c8 + 4);
            um2[0] = a.x; um2[1] = a.y; um2[2] = a.z; um2[3] = a.w; um2[4] = b.x; um2[5] = b.y; um2[6] = b.z; um2[7] = b.w; um1[0] = c.x; um1[1] = c.y; um1[2] = c.z; um1[3] = c.w; um1[4] = d.x; um1[5] = d.y; um1[6] = d.z; um1[7] = d.w; }
        else {
#pragma unroll
            for (int e = 0; e < 8; ++e) { um2[e] = 0.f; um1[e] = 0.f; } }
        float w0[8], w1[8], w2[8];
        { const f32x4 a = *(const f32x4*)(F.convw + c8), b = *(const f32x4*)(F.convw + c8 + 4); w0[0] = a.x; w0[1] = a.y; w0[2] = a.z; w0[3] = a.w; w0[4] = b.x; w0[5] = b.y; w0[6] = b.z; w0[7] = b.w; }
        { const f32x4 a = *(const f32x4*)(F.convw + CONV_W + c8), b = *(const f32x4*)(F.convw + CONV_W + c8 + 4); w1[0] = a.x; w1[1] = a.y; w1[2] = a.z; w1[3] = a.w; w1[4] = b.x; w1[5] = b.y; w1[6] = b.z; w1[7] = b.w; }
        { const f32x4 a = *(const f32x4*)(F.convw + 2 * CONV_W + c8), b = *(const f32x4*)(F.convw + 2 * CONV_W + c8 + 4); w2[0] = a.x; w2[1] = a.y; w2[2] = a.z; w2[3] = a.w; w2[4] = b.x; w2[5] = b.y; w2[6] = b.z; w2[7] = b.w; }
#pragma unroll
        for (int i = 0; i < 8; ++i) {
            float uc[8], gg[8], y[8]; unpack8(uw[i + 2], uc); unpack8(gw[i], gg);
#pragma unroll
            for (int e = 0; e < 8; ++e) y[e] = gg[e] * (w0[e] * um2[e] + w1[e] * um1[e] + w2[e] * uc[e]);
            u32x4 w; w.x = pk_bf16(y[0], y[1]); w.y = pk_bf16(y[2], y[3]); w.z = pk_bf16(y[4], y[5]); w.w = pk_bf16(y[6], y[7]); *(u32x4*)(A3 + (size_t)(row0 + i) * 2048 + 1024 + c8) = w;
            const int t = t0 + i;
            if (t >= T - 2) { float* op = oc + (size_t)(t - (T - 2)) * CONV_W + c8; *(f32x4*)op = (f32x4){uc[0], uc[1], uc[2], uc[3]}; *(f32x4*)(op + 4) = (f32x4){uc[4], uc[5], uc[6], uc[7]}; }
#pragma unroll
            for (int e = 0; e < 8; ++e) { um2[e] = um1[e]; um1[e] = uc[e]; }
        }
    }
}
__device__ __forceinline__ void p2_attention(Frame& F) {
    float s1 = 0.f, s2 = 0.f;
    for (int i = 0; i < DQK; ++i) { s1 += F.lq1[i] * F.lk1[i]; s2 += F.lq2[i] * F.lk2[i]; }
    const float lam = expf(s1) - expf(s2) + LAM_INIT;
    if (F.tid < DV) ((LAS float*)(F.lds + HN_OFF))[F.tid] = F.hnorm[F.tid] * (1.f - LAM_INIT);
    __syncthreads();
    if (F.G == 256) {
        const int bx = blockIdx.x, idx = bx >> 3, gi = (bx & 7) * 16 + (idx >> 1);
        const int bh = gi >> 2, sq = gi & 3;
        if ((idx & 1) == 0) {
            if (F.mode == 0 || F.mode == 1) for (int i = 0; i < 2; ++i) att::sample_unit(F, gi >> 2, (2 * gi + i) & 7, lam);
            if (F.mode == 0 || F.mode == 1) att::prompt_unit(F, bh >> 3, bh & 7, 1 + sq, lam);
        } else {
            if (F.mode == 0 || F.mode == 2 || F.mode == 3) conv_phase(F, gi, 128);
            if (F.mode == 0 || F.mode == 2) for (int i = 0; i < 3; ++i) {
                const int qb = (i == 0) ? ((sq == 3) ? 11 : 15 - sq) : (i == 1) ? ((sq == 0) ? 12 : (sq == 1) ? 8 : (sq == 2) ? 9 : 10) : ((sq == 0) ? 0 : 4 + sq);
                att::prompt_unit(F, bh >> 3, bh & 7, qb, lam); }
        }
    } else {
        conv_phase(F, F.vcu, F.G);
        for (int u = F.vcu; u < DEC_BATCH * NH; u += F.G) att::sample_unit(F, u >> 3, u & 7, lam);
        for (int u = F.vcu; u < BATCH * NH * 16; u += F.G) { const int bh = u >> 4, sq = u & 15; att::prompt_unit(F, bh >> 3, bh & 7, sq, lam); }
    }
}
__device__ __forceinline__ void p5_post(Frame& F) {
    const int gw = F.vcu * NWAVES + F.wave, NGW = F.G * NWAVES;
    for (int m = gw; m < M; m += NGW) {
        const GAS u32x4* yr = (const GAS u32x4*)(F.Y() + (size_t)m * D_MODEL) + F.lane;
        const float* xrow = (m < MP) ? F.xp + (size_t)m * D_MODEL : F.xs + (size_t)(m - MP) * D_MODEL;
        float* orow = (m < MP) ? F.out + O_YP + (size_t)m * D_MODEL : F.out + O_YS + (size_t)(m - MP) * D_MODEL;
        u32x4 yw[4]; f32x4 xv[4][2]; float s = 0.f;
#pragma unroll
        for (int j = 0; j < 4; ++j) { yw[j] = yr[64 * j]; const GAS f32x4* xr = (const GAS f32x4*)(xrow + 512 * j + 8 * F.lane); xv[j][0] = xr[0]; xv[j][1] = xr[1]; }
        float y[4][8];
#pragma unroll
        for (int j = 0; j < 4; ++j) { y[j][0] = bf_lo(yw[j].x); y[j][1] = bf_hi(yw[j].x); y[j][2] = bf_lo(yw[j].y); y[j][3] = bf_hi(yw[j].y); y[j][4] = bf_lo(yw[j].z); y[j][5] = bf_hi(yw[j].z); y[j][6] = bf_lo(yw[j].w); y[j][7] = bf_hi(yw[j].w);
#pragma unroll
            for (int e = 0; e < 8; ++e) s += y[j][e] * y[j][e]; }
        const float rs = 1.f / sqrtf(wave_sum(s) * (1.f / D_MODEL) + EPS);
#pragma unroll
        for (int j = 0; j < 4; ++j) { const GAS f32x4* gr = (const GAS f32x4*)(F.npost + 512 * j + 8 * F.lane); const f32x4 g0 = gr[0], g1 = gr[1];
            GAS f32x4* op = (GAS f32x4*)(orow + 512 * j + 8 * F.lane);
            op[0] = xv[j][0] + (f32x4){y[j][0], y[j][1], y[j][2], y[j][3]} * rs * g0; op[1] = xv[j][1] + (f32x4){y[j][4], y[j][5], y[j][6], y[j][7]} * rs * g1; }
    }
}

constexpr int N_LAUNCHES = MK_N_LAUNCHES, PER_PHASE = 6;
struct Args { const float* in[18]; float* out; unsigned char* ws; int ph_lo, ph_hi, li, pad; };
__global__ void __launch_bounds__(NWAVES * 64, 2) mk_fwd(Args args) {
    extern __shared__ __attribute__((aligned(16))) unsigned char lds[];
    Frame F;
    F.lds = (LAS unsigned char*)lds;
    F.MISC = (volatile LAS unsigned*)(F.lds + MISC_OFF);
    F.tid = threadIdx.x; F.lane = F.tid & 63; F.wave = __builtin_amdgcn_readfirstlane(F.tid >> 6);
    F.mode = args.pad; F.G = gridDim.x; { const int bx = blockIdx.x; F.vcu = (F.G % 8 == 0) ? (bx % 8) * (F.G / 8) + bx / 8 : bx; }
    unsigned char* ws = args.ws;
    F.ctl = (gu32*)(ws + WS_CTL);
    F.xp = args.in[0]; F.xs = args.in[1]; F.ck = args.in[2]; F.cv = args.in[3]; F.sconv = args.in[4]; F.npre = args.in[5]; F.npost = args.in[6]; F.w_in = args.in[7];
    F.lq1 = args.in[8]; F.lk1 = args.in[9]; F.lq2 = args.in[10]; F.lk2 = args.in[11]; F.hnorm = args.in[12]; F.convw = args.in[13]; F.wpa = args.in[14]; F.wpc = args.in[15];
    F.wout = args.in[16]; F.relb = args.in[17]; F.out = args.out;
    F.ws = ws;
    for (int u = F.tid; u < 512 / 4; u += NWAVES * 64) ((LAS unsigned*)(F.lds + LDSCTL_OFF))[u] = 0u;
    __syncthreads();
    XcdBarrier bar; bar.bar = (unsigned*)(F.ctl + CW_BAR); bar.x = 0; bar.st = nullptr;
    if (N_LAUNCHES != PER_PHASE) bar = xcd_barrier_post((unsigned*)(F.ctl + CW_BAR) + args.li * XCD_BAR_WORDS, F.MISC + 8);
#define GRID_BAR() do { if (N_LAUNCHES != PER_PHASE) xcd_barrier(bar); } while (0)
    const int lo = args.ph_lo, hi = args.ph_hi;
#ifndef PH_MASK
#define PH_MASK 63
#endif
#define IN(k) (((PH_MASK >> (k)) & 1) && lo <= (k) && (k) < hi)
#define BOTH(k) (IN(k) && IN((k) + 1))
    if (IN(0)) { p0_prologue(F); if (BOTH(0)) GRID_BAR(); }
    if (IN(1)) {
        pg8::Gemm g{F.XN(), F.W1T(), M, N_IN, D_MODEL}; pg8::StaticOrder S; S.init(M, N_IN, F.G, (int)blockIdx.x);
        pg8::Epi1 E{F.QB(), F.KB(), F.VB(), F.A3(), F.U(), F.RB(), F.S2(), F.out};
        pg8::gemm_phase<pg8::Epi1, pg8::StaticOrder, true, true>(F.lds, g, S, E);
        if (BOTH(1)) GRID_BAR();
    }
    if (IN(2)) { p2_attention(F); if (BOTH(2)) GRID_BAR(); }
    if (IN(3)) {
        pg8::Gemm g{F.A3(), F.W3T(), M, D_MODEL, D_MODEL}; pg8::StaticOrder S; S.init(M, D_MODEL, F.G, (int)blockIdx.x);
        pg8::Epi3 E{F.RB(), F.S2(), F.MB()};
        S.limit = (S.nwg / F.G) * F.G;
        pg8::gemm_phase<pg8::Epi3, pg8::StaticOrder, true, true>(F.lds, g, S, E);
        if (F.mode != 4) pg8::gemm_tail<pg8::Epi3>(F.lds, g, S, E);
        if (BOTH(3)) GRID_BAR();
    }
    if (IN(4)) {
        pg8::Gemm g{F.MB(), F.W4T(), M, D_MODEL, D_MODEL}; pg8::StaticOrder S; S.init(M, D_MODEL, F.G, (int)blockIdx.x);
        pg8::EpiY E{F.Y()};
        S.limit = (S.nwg / F.G) * F.G;
        pg8::gemm_phase<pg8::EpiY, pg8::StaticOrder, true, true>(F.lds, g, S, E);
        if (F.mode != 4) pg8::gemm_tail<pg8::EpiY>(F.lds, g, S, E);
        if (BOTH(4)) GRID_BAR();
    }
    if (IN(5)) { p5_post(F); }
#undef IN
#undef BOTH
}

extern "C" void kernel_launch(void* const* d_in, const int* in_sizes, int n_in, void* d_out, int out_size, void* d_ws, size_t ws_size, hipStream_t stream) {
    static int grid = 0;
    if (grid == 0) {
        if (n_in != 18 || (size_t)out_size != O_END || ws_size < WS_END) { fprintf(stderr, "kernel_launch: unexpected sizes n_in %d out %d ws %zu\n", n_in, out_size, ws_size); grid = -1; return; }
        int dev = 0, cus = 0, per_cu = 0;
        if (hipGetDevice(&dev) != hipSuccess || hipDeviceGetAttribute(&cus, hipDeviceAttributeMultiprocessorCount, dev) != hipSuccess) { grid = -1; return; }
        if (hipFuncSetAttribute((const void*)mk_fwd, hipFuncAttributeMaxDynamicSharedMemorySize, LDS_BYTES) != hipSuccess) { fprintf(stderr, "kernel_launch: hipFuncSetAttribute failed\n"); grid = -1; return; }
        if (hipOccupancyMaxActiveBlocksPerMultiprocessor(&per_cu, (const void*)mk_fwd, NWAVES * 64, LDS_BYTES) != hipSuccess || per_cu < 1) { fprintf(stderr, "kernel_launch: occupancy query says %d\n", per_cu); (void)hipGetLastError(); grid = -1; return; }
        grid = cus;
    }
    if (grid < 0) return;
    (void)hipMemsetAsync((char*)d_ws + WS_CTL, 0, CTL_ZERO_BYTES, stream);
    Args a{};
    for (int i = 0; i < 18; ++i) a.in[i] = (const float*)d_in[i];
    a.out = (float*)d_out; a.ws = (unsigned char*)d_ws;
    for (int li = 0; li < N_LAUNCHES; ++li) {
        a.ph_lo = (N_LAUNCHES == PER_PHASE) ? li : 0; a.ph_hi = (N_LAUNCHES == PER_PHASE) ? li + 1 : PER_PHASE; a.li = li;
        hipLaunchKernelGGL(mk_fwd, dim3(grid), dim3(NWAVES * 64), LDS_BYTES, stream, a);
    }
#if PROBE_LO >= 0
    a.ph_lo = PROBE_LO; a.ph_hi = PROBE_HI; a.li = 1; a.pad = PROBE_MODE;
    hipLaunchKernelGGL(mk_fwd, dim3(grid), dim3(NWAVES * 64), LDS_BYTES, stream, a);
#endif
}
```

```cpp
#include <hip/hip_runtime.h>
#include <cstdio>
#include <cstdint>

#ifndef MK_N_LAUNCHES
#define MK_N_LAUNCHES 1
#endif
#define PROBE_LO -1
#define PROBE_HI -1
#define PROBE_MODE 0

constexpr int D_MODEL = 2048, BATCH = 4, SEQ = 2048, DEC_BATCH = 32, DEC_SEQ = 16, PAST = 2048, NH = 8, DQK = 64, DV = 128, ATT_W = 1024, CONV_W = 1024, N_IN = 12288;
constexpr int MP = BATCH * SEQ, MS = DEC_BATCH * DEC_SEQ, M = MP + MS;
constexpr float EPS = 1e-6f, LOG2E = 1.4426950408889634f, QSCALE = 0.125f * LOG2E, LAM_INIT = 0.2f;
constexpr size_t O_YP = 0, O_YS = O_YP + (size_t)MP * D_MODEL, O_KP = O_YS + (size_t)MS * D_MODEL, O_VP = O_KP + (size_t)MP * 1024, O_CP = O_VP + (size_t)MP * 1024,
                 O_KS = O_CP + (size_t)BATCH * 2 * CONV_W, O_VS = O_KS + (size_t)MS * 1024, O_CS = O_VS + (size_t)MS * 1024, O_END = O_CS + (size_t)DEC_BATCH * 2 * CONV_W;

constexpr size_t MiB = 1u << 20;
constexpr size_t WS_CTL = 0, CTL_ZERO_BYTES = 64 * 1024;
constexpr size_t WS_W1T = 2 * MiB, WS_W3T = 50 * MiB, WS_W4T = 58 * MiB, WS_XN = 66 * MiB, WS_QB = 100 * MiB, WS_KB = 117 * MiB, WS_VB = 134 * MiB,
                 WS_A3 = 151 * MiB, WS_U = 185 * MiB, WS_RB = 202 * MiB, WS_S2 = 236 * MiB, WS_MB = 270 * MiB, WS_Y = 304 * MiB, WS_END = 372 * MiB;
constexpr int CW_TMO = 0, CW_BAR = 4096;

constexpr int RING_BYTES = 131072, LDSCTL_OFF = RING_BYTES, MISC_OFF = LDSCTL_OFF + 320, TAB_OFF = LDSCTL_OFF + 512, HN_OFF = TAB_OFF + 1024, LDS_BYTES = 147456;
constexpr int NWAVES = 8;

#define GAS __attribute__((address_space(1)))
#define LAS __attribute__((address_space(3)))
typedef unsigned short bf16_t;
typedef short bf16x8 __attribute__((ext_vector_type(8)));
typedef short s16x4 __attribute__((ext_vector_type(4)));
typedef float f32x4 __attribute__((ext_vector_type(4)));
typedef float f32x16 __attribute__((ext_vector_type(16)));
typedef unsigned u32x4 __attribute__((ext_vector_type(4)));
typedef unsigned u32x2 __attribute__((ext_vector_type(2)));
typedef float f32x2_t __attribute__((ext_vector_type(2)));
typedef __bf16 bf16x2_t __attribute__((ext_vector_type(2)));
typedef GAS unsigned gu32;
#define RLX_AGENT __ATOMIC_RELAXED, __HIP_MEMORY_SCOPE_AGENT
#define LDS_WAIT() asm volatile("s_waitcnt lgkmcnt(0)" ::: "memory")
#define VM_WAIT() asm volatile("s_waitcnt vmcnt(0)" ::: "memory")

__device__ __forceinline__ unsigned pk_bf16(float lo, float hi) { f32x2_t v = {lo, hi}; bf16x2_t b = __builtin_convertvector(v, bf16x2_t); return __builtin_bit_cast(unsigned, b); }
__device__ __forceinline__ float bf_lo(unsigned w) { return __uint_as_float(w << 16); }
__device__ __forceinline__ float bf_hi(unsigned w) { return __uint_as_float(w & 0xffff0000u); }
__device__ __forceinline__ float fast_exp2(float x) { return __builtin_amdgcn_exp2f(x); }
__device__ __forceinline__ float fast_rcp(float x) { return __builtin_amdgcn_rcpf(x); }
__device__ __forceinline__ float sigmoidf_(float x) { x = fminf(fmaxf(x, -30.f), 30.f); return fast_rcp(1.f + fast_exp2(-x * LOG2E)); }
__device__ __forceinline__ float siluf_(float x) { return x * sigmoidf_(x); }

__host__ __device__ __forceinline__ int orig_col(int v) {
    if (v < 4096) return v;
    const int vl = v & 255;
    if (v < 8192) { const int j = (v - 4096) >> 8, bj = vl >> 7, wc = (vl >> 5) & 3, fq = (vl >> 3) & 3, n = (vl >> 2) & 1, e = vl & 3; return 4096 + 1024 * (2 * bj + n) + 64 * j + 16 * wc + 4 * fq + e; }
    const int j = (v - 8192) >> 8, bj = vl >> 7; return 8192 + 2048 * bj + 128 * j + (vl & 127);
}

namespace pg8 {
#define PG8_LAS __attribute__((address_space(3)))
constexpr int BM = 256, BK = 64, HALF = 128, HTB = HALF * BK * 2, STAGE_BYTES = 8 * HTB, NXCD = 8, WGM = 8;
__host__ __device__ __forceinline__ int lds_byte(int r, int c) { const int st = (r >> 4) * 2 + (c >> 5), rr = r & 15, cc = c & 31, ob = rr * 64 + cc * 2; return st * 1024 + (ob ^ (((ob >> 9) & 1) << 5)); }
__host__ __device__ __forceinline__ void stage_rc(int b, int& R, int& C) { const int st = b / 1024, sb = b % 1024, swz = sb ^ (((sb >> 9) & 1) << 5); R = (st >> 1) * 16 + swz / 64; C = (st & 1) * 32 + (swz % 64) / 2; }
__host__ __device__ __forceinline__ int perm32(int rho) { const int n = rho >> 4, i = rho & 15; return 8 * (i >> 2) + 4 * n + (i & 3); }
struct Unit { int pm, pn; };
struct Gemm { const bf16_t* A; const bf16_t* Bt; int M, N, K; };
struct StaticOrder {
    int nM, nN, nwg, G, c, limit;
    __host__ __device__ void init(int M_, int N_, int G_, int c_) { nM = M_ / BM; nN = N_ / BM; nwg = nM * nN; G = G_; c = c_; limit = nwg; }
    __host__ __device__ void unit_of(int L, Unit& u) const {
        int wgid = L; { const int q = nwg / NXCD, r = nwg % NXCD, xcd = wgid % NXCD, off = wgid / NXCD; wgid = (xcd < r ? xcd * (q + 1) : r * (q + 1) + (xcd - r) * q) + off; }
        const int nig = WGM * nN, gid = wgid / nig, fm = gid * WGM, gsz = (nM - fm) < WGM ? (nM - fm) : WGM;
        u.pm = fm + ((wgid % nig) % gsz); u.pn = (wgid % nig) / gsz;
    }
    __host__ __device__ bool next(int i, Unit& u) const {
        const long L = (long)i * G + c; if (L >= limit) return false;
        int wgid = (int)L; { const int q = nwg / NXCD, r = nwg % NXCD, xcd = wgid % NXCD, off = wgid / NXCD; wgid = (xcd < r ? xcd * (q + 1) : r * (q + 1) + (xcd - r) * q) + off; }
        const int nig = WGM * nN, gid = wgid / nig, fm = gid * WGM, gsz = (nM - fm) < WGM ? (nM - fm) : WGM;
        u.pm = fm + ((wgid % nig) % gsz); u.pn = (wgid % nig) / gsz; return true;
    }
    __device__ __forceinline__ void a_ready(const Unit&) const {}
    __device__ __forceinline__ void done(const Unit&) const {}
};

struct Epi1 {
    static constexpr bool PERM = true, AFTER_DRAIN = false, HAS_MID = false; static constexpr int MID_T = 0;
    bf16_t *Qb, *Kb, *Vb, *A3, *U, *R, *S2; float* out;
    __device__ __forceinline__ void mid(f32x4 (&)[2][2][4][2], const Unit&, int, int, int, int) const {}
    __device__ __forceinline__ void operator()(const f32x4 (&acc)[2][2][4][2], const Unit& u, int wr, int wc, int fr, int fq) const {
        const int row0 = u.pm * BM + wr * 64 + fr, pn = u.pn, cl = wc * 32 + 8 * fq;
        if (pn < 4) {
#pragma unroll
            for (int ai = 0; ai < 2; ++ai)
#pragma unroll
                for (int m = 0; m < 4; ++m) { bf16_t* rp = Qb + (size_t)(row0 + ai * HALF + m * 16) * 1024 + pn * 256 + cl;
#pragma unroll
                    for (int bj = 0; bj < 2; ++bj) { const f32x4 v0 = acc[ai][bj][m][0] * QSCALE, v1 = acc[ai][bj][m][1] * QSCALE;
                        u32x4 w; w.x = pk_bf16(v0[0], v0[1]); w.y = pk_bf16(v0[2], v0[3]); w.z = pk_bf16(v1[0], v1[1]); w.w = pk_bf16(v1[2], v1[3]); *(u32x4*)(rp + bj * HALF) = w; } }
        } else if (pn < 12) {
            const bool isk = pn < 8; const int ct = (isk ? pn - 4 : pn - 8) * 256 + cl;
            bf16_t* B = isk ? Kb : Vb;
            float* O = (u.pm < MP / BM) ? out + (isk ? O_KP : O_VP) : out + (isk ? O_KS : O_VS) - (size_t)MP * 1024;
#pragma unroll
            for (int ai = 0; ai < 2; ++ai)
#pragma unroll
                for (int m = 0; m < 4; ++m) { const size_t ro = (size_t)(row0 + ai * HALF + m * 16) * 1024 + ct;
#pragma unroll
                    for (int bj = 0; bj < 2; ++bj) { const f32x4 v0 = acc[ai][bj][m][0], v1 = acc[ai][bj][m][1];
                        *(f32x4*)(O + ro + bj * HALF) = v0; *(f32x4*)(O + ro + bj * HALF + 4) = v1;
                        u32x4 w; w.x = pk_bf16(v0[0], v0[1]); w.y = pk_bf16(v0[2], v0[3]); w.z = pk_bf16(v1[0], v1[1]); w.w = pk_bf16(v1[2], v1[3]); *(u32x4*)(B + ro + bj * HALF) = w; } }
        } else if (pn < 16) {
#pragma unroll
            for (int ai = 0; ai < 2; ++ai)
#pragma unroll
                for (int m = 0; m < 4; ++m) { bf16_t* rp = A3 + (size_t)(row0 + ai * HALF + m * 16) * 2048 + (pn - 12) * 256 + cl;
#pragma unroll
                    for (int bj = 0; bj < 2; ++bj) { const f32x4 a = acc[ai][bj][m][0], b = acc[ai][bj][m][1];
                        u32x4 w; w.x = pk_bf16(siluf_(a[0]), siluf_(a[1])); w.y = pk_bf16(siluf_(a[2]), siluf_(a[3])); w.z = pk_bf16(siluf_(b[0]), siluf_(b[1])); w.w = pk_bf16(siluf_(b[2]), siluf_(b[3]));
                        *(u32x4*)(rp + bj * HALF) = w; } }
        } else if (pn < 32) {
            const int ch0 = (pn - 16) * 64 + wc * 16 + 4 * fq;
#pragma unroll
            for (int ai = 0; ai < 2; ++ai)
#pragma unroll
                for (int m = 0; m < 4; ++m) { const size_t row = (size_t)(row0 + ai * HALF + m * 16);
                    const f32x4 bg = acc[ai][0][m][0], cg = acc[ai][0][m][1], hh = acc[ai][1][m][0], zc = acc[ai][1][m][1];
                    const f32x4 uu = cg * hh; u32x2 wu; wu.x = pk_bf16(uu[0], uu[1]); wu.y = pk_bf16(uu[2], uu[3]); *(u32x2*)(U + row * 1024 + ch0) = wu;
                    u32x2 wg; wg.x = pk_bf16(bg[0] * siluf_(zc[0]), bg[1] * siluf_(zc[1])); wg.y = pk_bf16(bg[2] * siluf_(zc[2]), bg[3] * siluf_(zc[3])); *(u32x2*)(A3 + row * 2048 + 1024 + ch0) = wg; }
        } else {
            const int ch0 = (pn - 32) * 128 + cl;
#pragma unroll
            for (int ai = 0; ai < 2; ++ai)
#pragma unroll
                for (int m = 0; m < 4; ++m) { const size_t ro = (size_t)(row0 + ai * HALF + m * 16) * 2048 + ch0; float rr[8], ss[8];
#pragma unroll
                    for (int n = 0; n < 2; ++n)
#pragma unroll
                        for (int e = 0; e < 4; ++e) { const float ga = fminf(fmaxf(acc[ai][0][m][n][e], -30.f), 30.f), gc = fminf(fmaxf(acc[ai][1][m][n][e], -30.f), 30.f);
                            const float ea = 1.f + fast_exp2(-ga * LOG2E), ec = 1.f + fast_exp2(-gc * LOG2E); rr[4 * n + e] = ec * fast_rcp(ea); ss[4 * n + e] = fast_rcp(ec); }
                    u32x4 w; w.x = pk_bf16(rr[0], rr[1]); w.y = pk_bf16(rr[2], rr[3]); w.z = pk_bf16(rr[4], rr[5]); w.w = pk_bf16(rr[6], rr[7]); *(u32x4*)(R + ro) = w;
                    u32x4 s; s.x = pk_bf16(ss[0], ss[1]); s.y = pk_bf16(ss[2], ss[3]); s.z = pk_bf16(ss[4], ss[5]); s.w = pk_bf16(ss[6], ss[7]); *(u32x4*)(S2 + ro) = s; }
        }
    }
};
struct Epi3 {
    static constexpr bool PERM = true, AFTER_DRAIN = false, HAS_MID = true; static constexpr int MID_T = 16;
    const bf16_t *R, *S2; bf16_t* Mb;
    __device__ __forceinline__ void mid(f32x4 (&acc)[2][2][4][2], const Unit& u, int wr, int wc, int fr_, int fq_) const {
        int fr = fr_, fq = fq_; asm volatile("" : "+v"(fr), "+v"(fq));
        const bf16_t* base = R + (size_t)(u.pm * BM + wr * 64 + fr) * 2048 + (u.pn * BM + wc * 32 + 8 * fq);
        u32x4 w[2][4][2];
#pragma unroll
        for (int ai = 0; ai < 2; ++ai)
#pragma unroll
            for (int m = 0; m < 4; ++m)
#pragma unroll
                for (int bj = 0; bj < 2; ++bj) w[ai][m][bj] = *(const u32x4*)(base + (size_t)(ai * HALF + m * 16) * 2048 + bj * HALF);
#pragma unroll
        for (int ai = 0; ai < 2; ++ai)
#pragma unroll
            for (int m = 0; m < 4; ++m)
#pragma unroll
                for (int bj = 0; bj < 2; ++bj) { const u32x4 x = w[ai][m][bj];
                    acc[ai][bj][m][0] *= (f32x4){bf_lo(x.x), bf_hi(x.x), bf_lo(x.y), bf_hi(x.y)}; acc[ai][bj][m][1] *= (f32x4){bf_lo(x.z), bf_hi(x.z), bf_lo(x.w), bf_hi(x.w)}; }
    }
    __device__ __forceinline__ void operator()(const f32x4 (&acc)[2][2][4][2], const Unit& u, int wr, int wc, int fr_, int fq_) const {
        int fr = fr_, fq = fq_; asm volatile("" : "+v"(fr), "+v"(fq));
        const size_t ro0 = (size_t)(u.pm * BM + wr * 64 + fr) * 2048 + (u.pn * BM + wc * 32 + 8 * fq);
#pragma unroll
        for (int ai = 0; ai < 2; ++ai) {
            u32x4 sv[4][2];
#pragma unroll
            for (int m = 0; m < 4; ++m)
#pragma unroll
                for (int bj = 0; bj < 2; ++bj) sv[m][bj] = *(const u32x4*)(S2 + ro0 + (size_t)(ai * HALF + m * 16) * 2048 + bj * HALF);
#pragma unroll
            for (int m = 0; m < 4; ++m) { const size_t ro = ro0 + (size_t)(ai * HALF + m * 16) * 2048;
#pragma unroll
                for (int bj = 0; bj < 2; ++bj) { const u32x4 s = sv[m][bj]; const f32x4 a = acc[ai][bj][m][0], b = acc[ai][bj][m][1];
                    u32x4 w; w.x = pk_bf16(a[0] * bf_lo(s.x), a[1] * bf_hi(s.x)); w.y = pk_bf16(a[2] * bf_lo(s.y), a[3] * bf_hi(s.y)); w.z = pk_bf16(b[0] * bf_lo(s.z), b[1] * bf_hi(s.z)); w.w = pk_bf16(b[2] * bf_lo(s.w), b[3] * bf_hi(s.w));
                    *(u32x4*)(Mb + ro + bj * HALF) = w; } }
            asm volatile("" ::: "memory"); }
    }
    __device__ __forceinline__ void tail_mid(f32x4 (&acc)[2], int row, int col) const {
#pragma unroll
        for (int n = 0; n < 2; ++n) { const u32x2 r = *(const u32x2*)(R + (size_t)row * 2048 + col + 16 * n); acc[n] *= (f32x4){bf_lo(r.x), bf_hi(r.x), bf_lo(r.y), bf_hi(r.y)}; }
    }
    __device__ __forceinline__ void tail_out(const f32x4 (&acc)[2], int row, int col) const {
#pragma unroll
        for (int n = 0; n < 2; ++n) { const size_t ro = (size_t)row * 2048 + col + 16 * n; const u32x2 t = *(const u32x2*)(S2 + ro);
            u32x2 w; w.x = pk_bf16(acc[n][0] * bf_lo(t.x), acc[n][1] * bf_hi(t.x)); w.y = pk_bf16(acc[n][2] * bf_lo(t.y), acc[n][3] * bf_hi(t.y)); *(u32x2*)(Mb + ro) = w; }
    }
};
struct EpiY {
    static constexpr bool PERM = true, AFTER_DRAIN = false, HAS_MID = false; static constexpr int MID_T = 0;
    bf16_t* Y;
    __device__ __forceinline__ void mid(f32x4 (&)[2][2][4][2], const Unit&, int, int, int, int) const {}
    __device__ __forceinline__ void operator()(const f32x4 (&acc)[2][2][4][2], const Unit& u, int wr, int wc, int fr, int fq) const {
        const int row0 = u.pm * BM + wr * 64 + fr, col0 = u.pn * BM + wc * 32 + 8 * fq;
#pragma unroll
        for (int ai = 0; ai < 2; ++ai)
#pragma unroll
            for (int m = 0; m < 4; ++m) { bf16_t* rp = Y + (size_t)(row0 + ai * HALF + m * 16) * 2048 + col0;
#pragma unroll
                for (int bj = 0; bj < 2; ++bj) { const f32x4 a = acc[ai][bj][m][0], b = acc[ai][bj][m][1];
                    u32x4 w; w.x = pk_bf16(a[0], a[1]); w.y = pk_bf16(a[2], a[3]); w.z = pk_bf16(b[0], b[1]); w.w = pk_bf16(b[2], b[3]); *(u32x4*)(rp + bj * HALF) = w; } }
    }
    __device__ __forceinline__ void tail_mid(f32x4 (&)[2], int, int) const {}
    __device__ __forceinline__ void tail_out(const f32x4 (&acc)[2], int row, int col) const {
#pragma unroll
        for (int n = 0; n < 2; ++n) { u32x2 w; w.x = pk_bf16(acc[n][0], acc[n][1]); w.y = pk_bf16(acc[n][2], acc[n][3]); *(u32x2*)(Y + (size_t)row * 2048 + col + 16 * n) = w; }
    }
};

template <class Epi, class Sched, bool ALIGN_EPI = false, bool SP2 = false>
__device__ __forceinline__ void gemm_phase(PG8_LAS unsigned char* lds, const Gemm g, const Sched& S, const Epi& E) {
    const int tid = threadIdx.x, wid = __builtin_amdgcn_readfirstlane(tid >> 6), lane = tid & 63, wr = wid >> 2, wc = wid & 3, fr = lane & 15, fq = lane >> 4;
    const int K = g.K, nt = K / BK;
    unsigned voffA[2], voffB[2];
#pragma unroll
    for (int i = 0; i < 2; ++i) { int R, C; stage_rc(tid * 16 + i * 8192, R, C); const int Rb = Epi::PERM ? ((R & ~31) + perm32(R & 31)) : R;
        voffA[i] = (unsigned)(R * K + C) * 2u; voffB[i] = (unsigned)(Rb * K + C) * 2u; }
    const size_t kstep = (size_t)(BK * 2);
    const size_t hstep = (size_t)HALF * K * 2;
    const size_t tstep = 2 * hstep;
    const unsigned ldsw = (unsigned)wid * 1024u;
    const int aoff = lds_byte(wr * 64 + fr, fq * 8), boff = lds_byte(wc * 32 + fr, fq * 8);
#define PG8_SA(b, h) (((b) * 2 + (h)) * HTB)
#define PG8_SB(b, h) ((4 + (b) * 2 + (h)) * HTB)
#define PG8_STAGE(bufoff, gbase, voff) do { _Pragma("unroll") for (int _i = 0; _i < 2; ++_i) \
        __builtin_amdgcn_global_load_lds((const unsigned*)((const char*)(gbase) + (voff)[_i]), (PG8_LAS unsigned*)(lds + (bufoff) + ldsw + _i * 8192), 16, 0, 0); } while (0)
#define PG8_LDA(dst, b, h) do { _Pragma("unroll") for (int m = 0; m < 4; ++m) _Pragma("unroll") for (int k = 0; k < 2; ++k) dst[m][k] = *(const PG8_LAS bf16x8*)(lds + PG8_SA(b, h) + aoff + m * 2048 + k * 1024); } while (0)
#define PG8_LDB(dst, b, h) do { _Pragma("unroll") for (int n = 0; n < 2; ++n) _Pragma("unroll") for (int k = 0; k < 2; ++k) dst[n][k] = *(const PG8_LAS bf16x8*)(lds + PG8_SB(b, h) + boff + n * 2048 + k * 1024); } while (0)
#define PG8_MMA(ai, bj, At, Bt) do { __builtin_amdgcn_s_setprio(1); _Pragma("unroll") for (int m = 0; m < 4; ++m) _Pragma("unroll") for (int n = 0; n < 2; ++n) _Pragma("unroll") for (int k = 0; k < 2; ++k) \
        acc[ai][bj][m][n] = __builtin_amdgcn_mfma_f32_16x16x32_bf16(Bt[n][k], At[m][k], acc[ai][bj][m][n], 0, 0, 0); __builtin_amdgcn_s_setprio(0); } while (0)
#define PG8_WAIT_V(n) asm volatile("s_waitcnt vmcnt(" #n ")" ::: "memory")
#define PG8_WAIT_L(n) asm volatile("s_waitcnt lgkmcnt(" #n ")" ::: "memory")
#define PG8_BAR __builtin_amdgcn_s_barrier()
#define PG8_SCHED __builtin_amdgcn_sched_barrier(0)
    Unit cur, nxt; int ui = 0;
    if (!S.next(0, cur)) return;
    f32x4 acc[2][2][4][2];
#pragma unroll
    for (int a = 0; a < 2; ++a)
#pragma unroll
        for (int b = 0; b < 2; ++b)
#pragma unroll
            for (int m = 0; m < 4; ++m)
#pragma unroll
                for (int n = 0; n < 2; ++n) acc[a][b][m][n] = (f32x4){0.f, 0.f, 0.f, 0.f};
    bf16x8 At[4][2], B0[2][2], B1[2][2];
    const char* cA = (const char*)g.A + (size_t)cur.pm * tstep; const char* cB = (const char*)g.Bt + (size_t)cur.pn * tstep;
    S.a_ready(cur);
    if constexpr (SP2) {
        PG8_STAGE(PG8_SB(0, 0), cB, voffB); PG8_STAGE(PG8_SB(0, 1), cB + hstep, voffB); PG8_STAGE(PG8_SA(0, 0), cA, voffA); PG8_STAGE(PG8_SA(0, 1), cA + hstep, voffA);
        if (wr == 1) PG8_BAR;
        PG8_WAIT_V(2); PG8_BAR;
        PG8_STAGE(PG8_SB(1, 0), cB + kstep, voffB); PG8_STAGE(PG8_SA(1, 0), cA + kstep, voffA); PG8_STAGE(PG8_SB(1, 1), cB + hstep + kstep, voffB);
        PG8_WAIT_V(6); PG8_BAR;
    } else {
        PG8_STAGE(PG8_SB(0, 0), cB, voffB); PG8_STAGE(PG8_SA(0, 0), cA, voffA); PG8_STAGE(PG8_SB(0, 1), cB + hstep, voffB); PG8_STAGE(PG8_SA(0, 1), cA + hstep, voffA);
        if (wr == 1) PG8_BAR;
        PG8_WAIT_V(4); PG8_BAR;
        PG8_STAGE(PG8_SB(1, 0), cB + kstep, voffB); PG8_STAGE(PG8_SA(1, 0), cA + kstep, voffA); PG8_STAGE(PG8_SB(1, 1), cB + hstep + kstep, voffB);
        PG8_WAIT_V(6); PG8_BAR;
    }
    for (;;) {
        const bool has_next = S.next(ui + 1, nxt);
        const char* nA = has_next ? (const char*)g.A + (size_t)nxt.pm * tstep : cA; const char* nB = has_next ? (const char*)g.Bt + (size_t)nxt.pn * tstep : cB;
        for (int t = 0; t < nt; t += 2) {
            if constexpr (Epi::HAS_MID) { if (t == Epi::MID_T) E.mid(acc, cur, wr, wc, fr, fq); }
            const bool last = (t == nt - 2);
            const char* a1 = cA + (size_t)(t + 1) * kstep;
            const char* a2 = last ? nA : cA + (size_t)(t + 2) * kstep; const char* b2 = last ? nB : cB + (size_t)(t + 2) * kstep;
            const char* a3 = a2 + kstep; const char* b3 = b2 + kstep;
            if (last && has_next) S.a_ready(nxt);
            if constexpr (SP2) {
            PG8_LDB(B0, 0, 0); PG8_LDB(B1, 0, 1); PG8_SCHED; PG8_LDA(At, 0, 0); PG8_STAGE(PG8_SA(1, 1), a1 + hstep, voffA);
            PG8_WAIT_V(8); PG8_WAIT_L(0); PG8_BAR; PG8_MMA(0, 0, At, B0); PG8_MMA(0, 1, At, B1); PG8_BAR; PG8_SCHED;
            PG8_LDA(At, 0, 1); PG8_STAGE(PG8_SB(0, 0), b2, voffB); PG8_STAGE(PG8_SB(0, 1), b2 + hstep, voffB); PG8_STAGE(PG8_SA(0, 0), a2, voffA);
            PG8_WAIT_V(8); PG8_WAIT_L(0); PG8_BAR; PG8_MMA(1, 0, At, B0); PG8_MMA(1, 1, At, B1); PG8_BAR; PG8_SCHED;
            PG8_LDB(B0, 1, 0); PG8_LDB(B1, 1, 1); PG8_SCHED; PG8_LDA(At, 1, 0); PG8_STAGE(PG8_SA(0, 1), a2 + hstep, voffA);
            PG8_WAIT_V(8); PG8_WAIT_L(0); PG8_BAR; PG8_MMA(0, 0, At, B0); PG8_MMA(0, 1, At, B1); PG8_BAR; PG8_SCHED;
            PG8_LDA(At, 1, 1); PG8_STAGE(PG8_SB(1, 0), b3, voffB); PG8_STAGE(PG8_SB(1, 1), b3 + hstep, voffB); PG8_STAGE(PG8_SA(1, 0), a3, voffA);
            PG8_WAIT_V(8); PG8_WAIT_L(0); PG8_BAR; PG8_MMA(1, 0, At, B0); PG8_MMA(1, 1, At, B1); PG8_BAR; PG8_SCHED;
            } else {
            PG8_LDB(B0, 0, 0); PG8_SCHED; PG8_LDA(At, 0, 0); PG8_STAGE(PG8_SA(1, 1), a1 + hstep, voffA);
            PG8_WAIT_L(8); PG8_BAR; PG8_WAIT_L(0); PG8_MMA(0, 0, At, B0); PG8_BAR; PG8_SCHED;
            PG8_LDB(B1, 0, 1); PG8_STAGE(PG8_SB(0, 0), b2, voffB);
            PG8_BAR; PG8_WAIT_L(0); PG8_MMA(0, 1, At, B1); PG8_BAR;
            PG8_LDA(At, 0, 1); PG8_STAGE(PG8_SA(0, 0), a2, voffA);
            PG8_BAR; PG8_WAIT_L(0); PG8_MMA(1, 0, At, B0); PG8_BAR; PG8_SCHED;
            PG8_STAGE(PG8_SB(0, 1), b2 + hstep, voffB);
            PG8_WAIT_V(6); PG8_BAR; PG8_MMA(1, 1, At, B1); PG8_BAR;
            PG8_LDB(B0, 1, 0); PG8_SCHED; PG8_LDA(At, 1, 0); PG8_STAGE(PG8_SA(0, 1), a2 + hstep, voffA);
            PG8_WAIT_L(8); PG8_BAR; PG8_WAIT_L(0); PG8_MMA(0, 0, At, B0); PG8_BAR; PG8_SCHED;
            PG8_LDB(B1, 1, 1); PG8_STAGE(PG8_SB(1, 0), b3, voffB);
            PG8_BAR; PG8_WAIT_L(0); PG8_MMA(0, 1, At, B1); PG8_BAR;
            PG8_LDA(At, 1, 1); PG8_STAGE(PG8_SA(1, 0), a3, voffA);
            PG8_BAR; PG8_WAIT_L(0); PG8_MMA(1, 0, At, B0); PG8_BAR; PG8_SCHED;
            PG8_STAGE(PG8_SB(1, 1), b3 + hstep, voffB);
            PG8_WAIT_V(6); PG8_BAR; PG8_MMA(1, 1, At, B1); PG8_BAR;
            }
        }
        if constexpr (ALIGN_EPI) { if (wr == 0) PG8_BAR; }
        if constexpr (!Epi::AFTER_DRAIN) { E(acc, cur, wr, wc, fr, fq); S.done(cur); }
        if (!has_next) break;
#pragma unroll
        for (int a = 0; a < 2; ++a)
#pragma unroll
            for (int b = 0; b < 2; ++b)
#pragma unroll
                for (int m = 0; m < 4; ++m)
#pragma unroll
                    for (int n = 0; n < 2; ++n) acc[a][b][m][n] = (f32x4){0.f, 0.f, 0.f, 0.f};
        cur = nxt; cA = nA; cB = nB; ++ui;
        if constexpr (ALIGN_EPI) { if (wr == 1) PG8_BAR; }
    }
    PG8_WAIT_V(0);
    if constexpr (!ALIGN_EPI) { if (wr == 0) PG8_BAR; }
    PG8_BAR;
#undef PG8_SA
#undef PG8_SB
#undef PG8_STAGE
#undef PG8_LDA
#undef PG8_LDB
#undef PG8_MMA
#undef PG8_WAIT_V
#undef PG8_WAIT_L
#undef PG8_BAR
#undef PG8_SCHED
}
template <class Epi>
__device__ __forceinline__ void gemm_tail(PG8_LAS unsigned char* lds, const Gemm g, const StaticOrder& S, const Epi& E) {
    int tid_ = threadIdx.x; asm volatile("" : "+v"(tid_));
    const int tid = tid_, wid = __builtin_amdgcn_readfirstlane(tid >> 6), lane = tid & 63, fr = lane & 15, fq = lane >> 4, wm = wid >> 1, wn = wid & 1;
    const int K = g.K, nt = K / 64, nleft = S.nwg - S.limit;
    constexpr int SLOT = 16384, NS = 8;
    for (int st = S.c; st < nleft * 16; st += S.G) {
        Unit u; S.unit_of(S.limit + (st >> 4), u); const int sub = st & 15;
        const int row0 = u.pm * BM + (sub >> 2) * 64, col0 = u.pn * BM + (sub & 3) * 64;
        const int pr = 8 * wid + (lane >> 3), pc = (lane & 7) ^ (pr & 7);
        const char* srcA = (const char*)(g.A + (size_t)(row0 + pr) * K) + pc * 16;
        const char* srcB = (const char*)(g.Bt + (size_t)(col0 + pr) * K) + pc * 16;
        const unsigned dA = (unsigned)wid * 1024u, dB = 8192u + (unsigned)wid * 1024u;
#define PG8_TSTAGE(kt) do { PG8_LAS unsigned char* sl_ = lds + ((kt) & (NS - 1)) * SLOT; \
            __builtin_amdgcn_global_load_lds((const unsigned*)(srcA + (size_t)(kt) * 128), (PG8_LAS unsigned*)(sl_ + dA), 16, 0, 0); \
            __builtin_amdgcn_global_load_lds((const unsigned*)(srcB + (size_t)(kt) * 128), (PG8_LAS unsigned*)(sl_ + dB), 16, 0, 0); } while (0)
        f32x4 acc[2];
        acc[0] = (f32x4){0.f, 0.f, 0.f, 0.f}; acc[1] = (f32x4){0.f, 0.f, 0.f, 0.f};
        const int ra = 16 * wm + fr, rb0 = 32 * wn + fr, rb1 = rb0 + 16;
#pragma unroll
        for (int kt = 0; kt < NS - 1; ++kt) PG8_TSTAGE(kt);
        for (int kt = 0; kt < nt; ++kt) {
            if (Epi::HAS_MID && kt == Epi::MID_T) E.tail_mid(acc, row0 + ra, col0 + 32 * wn + 4 * fq);
            const int newer = nt - 1 - kt;
            if (newer >= 6) asm volatile("s_waitcnt vmcnt(12)" ::: "memory");
            else if (newer == 5) asm volatile("s_waitcnt vmcnt(10)" ::: "memory");
            else if (newer == 4) asm volatile("s_waitcnt vmcnt(8)" ::: "memory");
            else if (newer == 3) asm volatile("s_waitcnt vmcnt(6)" ::: "memory");
            else if (newer == 2) asm volatile("s_waitcnt vmcnt(4)" ::: "memory");
            else if (newer == 1) asm volatile("s_waitcnt vmcnt(2)" ::: "memory");
            else asm volatile("s_waitcnt vmcnt(0)" ::: "memory");
            __builtin_amdgcn_s_barrier();
            if (kt + NS - 1 < nt) PG8_TSTAGE(kt + NS - 1);
            const PG8_LAS unsigned char* sl = lds + (kt & (NS - 1)) * SLOT;
            bf16x8 a[2], b0[2], b1[2];
#pragma unroll
            for (int h = 0; h < 2; ++h) { const int c = 4 * h + fq;
                a[h] = *(const PG8_LAS bf16x8*)(sl + ra * 128 + ((c ^ (ra & 7)) * 16));
                b0[h] = *(const PG8_LAS bf16x8*)(sl + 8192 + rb0 * 128 + ((c ^ (rb0 & 7)) * 16));
                b1[h] = *(const PG8_LAS bf16x8*)(sl + 8192 + rb1 * 128 + ((c ^ (rb1 & 7)) * 16)); }
#pragma unroll
            for (int h = 0; h < 2; ++h) { acc[0] = __builtin_amdgcn_mfma_f32_16x16x32_bf16(b0[h], a[h], acc[0], 0, 0, 0); acc[1] = __builtin_amdgcn_mfma_f32_16x16x32_bf16(b1[h], a[h], acc[1], 0, 0, 0); }
        }
        E.tail_out(acc, row0 + ra, col0 + 32 * wn + 4 * fq);
        asm volatile("s_waitcnt lgkmcnt(0)" ::: "memory"); __builtin_amdgcn_s_barrier();
#undef PG8_TSTAGE
    }
}
}

#define XB_TMO      128
#define XB_XCNT(j)  (256  + 64 * (j))
#define XB_XSUB(j)  (1280 + 64 * (j))
#define XB_XGEN(j)  (2304 + 64 * (j))
#define XB_TOP      3328
#define XB_TOPGEN   3392
#define XCD_BAR_WORDS 3456
#define XB_SPIN_CAP (1u << 18)
__device__ __forceinline__ unsigned xb_ld(unsigned* p)              { return __hip_atomic_load(p, __ATOMIC_RELAXED, __HIP_MEMORY_SCOPE_AGENT); }
__device__ __forceinline__ unsigned xb_add(unsigned* p, unsigned v) { return __hip_atomic_fetch_add(p, v, __ATOMIC_RELAXED, __HIP_MEMORY_SCOPE_AGENT); }
__device__ __forceinline__ unsigned xb_xcc_id() { return (unsigned)__builtin_amdgcn_s_getreg((3 << 11) | 20) & 0xFu; }
#define XB_SPIN(cond, bar) do { unsigned _sp = 0; while (cond) { __builtin_amdgcn_s_sleep(1); \
    if ((++_sp & 255u) == 0u) { if (xb_ld(&(bar)[XB_TMO])) break; if (_sp > XB_SPIN_CAP) { atomicAdd(&(bar)[XB_TMO], 1u); break; } } } } while (0)
struct XcdBarrier { unsigned* bar; unsigned x; volatile LAS unsigned* st; };
__device__ __forceinline__ XcdBarrier xcd_barrier_post(unsigned* bar, volatile LAS unsigned* st) {
    XcdBarrier b; b.bar = bar; b.x = xb_xcc_id(); b.st = st;
    if (threadIdx.x == 0) (void)xb_add(&bar[XB_XCNT(b.x)], 1u);
    return b;
}
__device__ __forceinline__ void xcd_barrier_complete(unsigned* bar, unsigned x, unsigned& nloc, unsigned& nx) {
    const unsigned G = gridDim.x * gridDim.y * gridDim.z;
    unsigned sum, cnt, mine, sp = 0u;
    for (;;) {
        sum = 0u; cnt = 0u; mine = 0u;
#pragma unroll
        for (unsigned j = 0; j < 16; ++j) { const unsigned c = xb_ld(&bar[XB_XCNT(j)]); sum += c; cnt += (c > 0u) ? 1u : 0u; mine = (j == x) ? c : mine; }
        if (sum == G) break;
        __builtin_amdgcn_s_sleep(1);
        if ((++sp & 255u) == 0u) { if (xb_ld(&bar[XB_TMO])) break; if (sp > XB_SPIN_CAP) { atomicAdd(&bar[XB_TMO], 1u); break; } }
    }
    nloc = mine > 0u ? mine : 1u; nx = cnt > 0u ? cnt : 1u;
}
__device__ __forceinline__ void xcd_barrier(const XcdBarrier& b) {
    asm volatile("s_waitcnt vmcnt(0)" ::: "memory");
    __syncthreads();
    if (threadIdx.x == 0) {
        unsigned* bar = b.bar;
        __builtin_amdgcn_s_waitcnt(0);
        unsigned nloc = b.st[0], nx = b.st[1];
        if (nloc == 0u) { xcd_barrier_complete(bar, b.x, nloc, nx); b.st[0] = nloc; b.st[1] = nx; }
        const unsigned old = xb_add(&bar[XB_XSUB(b.x)], 1u);
        const unsigned gen = old / nloc;
        if (old + 1u == (gen + 1u) * nloc) {
            __builtin_amdgcn_fence(__ATOMIC_RELEASE, "agent");
            asm volatile("s_waitcnt vmcnt(0)" ::: "memory");
            const unsigned og = xb_add(&bar[XB_TOP], 1u);
            const unsigned tg = og / nx;
            if (og + 1u == (tg + 1u) * nx) xb_add(&bar[XB_TOPGEN], 1u);
            else XB_SPIN(xb_ld(&bar[XB_TOPGEN]) == tg, bar);
            __builtin_amdgcn_fence(__ATOMIC_ACQUIRE, "agent");
            xb_add(&bar[XB_XGEN(b.x)], 1u);
            asm volatile("s_waitcnt vmcnt(0)" ::: "memory");
        } else {
            XB_SPIN(xb_ld(&bar[XB_XGEN(b.x)]) == gen, bar);
            __builtin_amdgcn_fence(__ATOMIC_ACQUIRE, "agent");
            asm volatile("s_waitcnt vmcnt(0)" ::: "memory");
        }
    }
    __syncthreads();
}

struct Frame {
    LAS unsigned char* lds;
    volatile LAS unsigned* MISC;
    gu32* ctl;
    int tid, lane, wave, vcu, G, mode;
    const float *xp, *xs, *ck, *cv, *sconv, *npre, *npost, *w_in, *lq1, *lk1, *lq2, *lk2, *hnorm, *convw, *wpa, *wpc, *wout, *relb;
    float* out;
    unsigned char* ws;
    __device__ __forceinline__ bf16_t* W1T() const { return (bf16_t*)(ws + WS_W1T); }
    __device__ __forceinline__ bf16_t* W3T() const { return (bf16_t*)(ws + WS_W3T); }
    __device__ __forceinline__ bf16_t* W4T() const { return (bf16_t*)(ws + WS_W4T); }
    __device__ __forceinline__ bf16_t* XN() const { return (bf16_t*)(ws + WS_XN); }
    __device__ __forceinline__ bf16_t* QB() const { return (bf16_t*)(ws + WS_QB); }
    __device__ __forceinline__ bf16_t* KB() const { return (bf16_t*)(ws + WS_KB); }
    __device__ __forceinline__ bf16_t* VB() const { return (bf16_t*)(ws + WS_VB); }
    __device__ __forceinline__ bf16_t* A3() const { return (bf16_t*)(ws + WS_A3); }
    __device__ __forceinline__ bf16_t* U() const { return (bf16_t*)(ws + WS_U); }
    __device__ __forceinline__ bf16_t* RB() const { return (bf16_t*)(ws + WS_RB); }
    __device__ __forceinline__ bf16_t* S2() const { return (bf16_t*)(ws + WS_S2); }
    __device__ __forceinline__ bf16_t* MB() const { return (bf16_t*)(ws + WS_MB); }
    __device__ __forceinline__ bf16_t* Y() const { return (bf16_t*)(ws + WS_Y); }
};
__device__ __forceinline__ float wave_sum(float v) {
#pragma unroll
    for (int o = 1; o < 64; o <<= 1) v += __shfl_xor(v, o);
    return v;
}

template <class ColMap>
__device__ __forceinline__ void p0_tr_item(const float* W, int ldw, bf16_t* WT, int ldt, int koff, int k0, int n0, const ColMap& cm, LAS float* scr, int lane) {
    const int sc = cm(n0 + (lane & 31));
#pragma unroll 8
    for (int i = 0; i < 32; ++i) { const int kk = 2 * i + (lane >> 5); scr[kk * 33 + (lane & 31)] = W[(size_t)(k0 + kk) * ldw + sc]; }
    LDS_WAIT(); asm volatile("" ::: "memory");
    const int c = lane & 7;
#pragma unroll
    for (int j = 0; j < 4; ++j) { const int n = (lane >> 3) + 8 * j; const LAS float* s = scr + (8 * c) * 33 + n;
        u32x4 o; o.x = pk_bf16(s[0 * 33], s[1 * 33]); o.y = pk_bf16(s[2 * 33], s[3 * 33]); o.z = pk_bf16(s[4 * 33], s[5 * 33]); o.w = pk_bf16(s[6 * 33], s[7 * 33]);
        *(GAS u32x4*)(WT + (size_t)(n0 + n) * ldt + koff + k0 + 8 * c) = o; }
    LDS_WAIT(); asm volatile("" ::: "memory");
}
struct CmId { __device__ __forceinline__ int operator()(int n) const { return n; } };
struct CmW1 { __device__ __forceinline__ int operator()(int n) const { return orig_col(n); } };
__device__ __forceinline__ void rms_row_to_bf16(const float* xrow, const float* g, bf16_t* orow, int lane) {
    const GAS f32x4* xr = (const GAS f32x4*)xrow + lane; const GAS f32x4* gr = (const GAS f32x4*)g + lane;
    f32x4 v[8]; float s = 0.f;
#pragma unroll
    for (int j = 0; j < 8; ++j) { v[j] = xr[64 * j]; s += (v[j].x * v[j].x + v[j].y * v[j].y) + (v[j].z * v[j].z + v[j].w * v[j].w); }
    const float rs = 1.f / sqrtf(wave_sum(s) * (1.f / D_MODEL) + EPS);
    GAS u32x2* o8 = (GAS u32x2*)orow + lane;
#pragma unroll
    for (int j = 0; j < 8; ++j) { const f32x4 gg = gr[64 * j]; u32x2 w; w.x = pk_bf16(v[j].x * rs * gg.x, v[j].y * rs * gg.y); w.y = pk_bf16(v[j].z * rs * gg.z, v[j].w * rs * gg.w); o8[64 * j] = w; }
}
__device__ __forceinline__ void p0_prologue(Frame& F) {
    LAS float* scr = (LAS float*)(F.lds + F.wave * 16384);
    const int gw = F.vcu * NWAVES + F.wave, NGW = F.G * NWAVES;
    constexpr int I_1 = (D_MODEL / 64) * (N_IN / 32), I_3 = (1024 / 64) * (D_MODEL / 32), I_4 = (D_MODEL / 64) * (D_MODEL / 32);
    constexpr int NITEMS = I_1 + 2 * I_3 + I_4;
    for (int it = gw; it < NITEMS; it += NGW) {
        int r = it;
        if (r < I_1) { const int nblk = N_IN / 32, kb = r / nblk, nb = r % nblk; p0_tr_item(F.w_in, N_IN, F.W1T(), D_MODEL, 0, 64 * kb, 32 * nb, CmW1{}, scr, F.lane); continue; } r -= I_1;
        if (r < I_3) { const int nblk = D_MODEL / 32, kb = r / nblk, nb = r % nblk; p0_tr_item(F.wpa, D_MODEL, F.W3T(), 2048, 0, 64 * kb, 32 * nb, CmId{}, scr, F.lane); continue; } r -= I_3;
        if (r < I_3) { const int nblk = D_MODEL / 32, kb = r / nblk, nb = r % nblk; p0_tr_item(F.wpc, D_MODEL, F.W3T(), 2048, 1024, 64 * kb, 32 * nb, CmId{}, scr, F.lane); continue; } r -= I_3;
        { const int nblk = D_MODEL / 32, kb = r / nblk, nb = r % nblk; p0_tr_item(F.wout, D_MODEL, F.W4T(), 2048, 0, 64 * kb, 32 * nb, CmId{}, scr, F.lane); }
    }
    for (int m = gw; m < M; m += NGW) { const float* xr = (m < MP) ? F.xp + (size_t)m * D_MODEL : F.xs + (size_t)(m - MP) * D_MODEL; rms_row_to_bf16(xr, F.npre, F.XN() + (size_t)m * D_MODEL, F.lane); }
}

namespace att {
constexpr int L_K = 0, L_V = 32768, L_STG = 65536, TILEB = 16384;
constexpr float THR = 8.f;
__device__ __forceinline__ int off_b(int row, int ch) { return 256 * row + 16 * (ch ^ (((row & 3) << 2) | ((row >> 2) & 3))); }
__device__ __forceinline__ int crow(int r, int hi) { return (r & 3) + 8 * (r >> 2) + 4 * hi; }
typedef short v4i16_t __attribute__((ext_vector_type(4)));
__device__ __forceinline__ s16x4 vtr(LAS const unsigned char* p) { return __builtin_bit_cast(s16x4, __builtin_amdgcn_ds_read_tr16_b64_v4i16((LAS v4i16_t*)p)); }
#define MFMA32(a, b, c) __builtin_amdgcn_mfma_f32_32x32x16_bf16((a), (b), (c), 0, 0, 0)
__device__ __forceinline__ int rel_bucket(int rel) {
    const int ret = rel > 0 ? 16 : 0, n = rel < 0 ? -rel : rel;
    if (n < 8) return ret + n;
    int large = 8 + (31 - __clz(n * n)) - 6; large = large > 15 ? 15 : large;
    return ret + large;
}
__device__ __forceinline__ void qk_map(f32x16& p0, f32x16& p1, LAS const unsigned char* kbuf, LAS const unsigned char* qbuf, int map, const f32x16& cinit, int r32, int hi) {
    const int xr = ((r32 & 3) << 2) | ((r32 >> 2) & 3), rb = 256 * r32;
#pragma unroll
    for (int s = 0; s < 4; ++s) {
        const int o = rb + 16 * ((map * 8 + 2 * s + hi) ^ xr);
        const bf16x8 qf = *(LAS const bf16x8*)(qbuf + o);
        const bf16x8 a0 = *(LAS const bf16x8*)(kbuf + o), a1 = *(LAS const bf16x8*)(kbuf + o + 8192);
        if (s == 0) { p0 = MFMA32(a0, qf, cinit); p1 = MFMA32(a1, qf, cinit); } else { p0 = MFMA32(a0, qf, p0); p1 = MFMA32(a1, qf, p1); }
    }
}
__device__ __forceinline__ float rowmax32(const f32x16& p0, const f32x16& p1) {
    float a = __builtin_fmaxf(p0[0], p1[0]);
#pragma unroll
    for (int r = 1; r < 16; ++r) a = __builtin_fmaxf(__builtin_fmaxf(a, p0[r]), p1[r]);
    return __builtin_fmaxf(a, __shfl_xor(a, 32));
}
template <int NB, bool PIPE = false>
__device__ __forceinline__ void softmax_tile(f32x16& p0, f32x16& p1, float& m, float& l, f32x16 (&o)[NB], f32x16& negm, float c15, bool first, f32x16* pn0 = nullptr, f32x16* pn1 = nullptr) {
    if (first) { const float rm = rowmax32(p0, p1); m = rm;
#pragma unroll
        for (int r = 0; r < 16; ++r) { p0[r] -= rm; p1[r] -= rm; negm[r] = c15 - rm; if (PIPE) { (*pn0)[r] -= rm; (*pn1)[r] -= rm; } } }
    f32x16 e0, e1; float s = 0.f;
#pragma unroll
    for (int r = 0; r < 16; ++r) { e0[r] = fast_exp2(p0[r]); e1[r] = fast_exp2(p1[r]); s += e0[r] + e1[r]; }
    if (__builtin_expect(__any(!(s <= 4096.f)), 0)) {
        const float rm = rowmax32(p0, p1), dl = fmaxf(rm, 0.f); m += dl;
        const float f = fast_exp2(-dl); l *= f; s = 0.f;
#pragma unroll
        for (int r = 0; r < 16; ++r) { e0[r] = fast_exp2(p0[r] - dl); e1[r] = fast_exp2(p1[r] - dl); s += e0[r] + e1[r]; negm[r] = c15 - m; if (PIPE) { (*pn0)[r] -= dl; (*pn1)[r] -= dl; } }
#pragma unroll
        for (int i = 0; i < NB; ++i)
#pragma unroll
            for (int r = 0; r < 16; ++r) o[i][r] *= f;
    }
    l += s; p0 = e0; p1 = e1;
}
__device__ __forceinline__ bf16x8 pack8(const f32x16& p, int s) {
    u32x4 w; w.x = pk_bf16(p[8 * s], p[8 * s + 1]); w.y = pk_bf16(p[8 * s + 2], p[8 * s + 3]); w.z = pk_bf16(p[8 * s + 4], p[8 * s + 5]); w.w = pk_bf16(p[8 * s + 6], p[8 * s + 7]);
    return __builtin_bit_cast(bf16x8, w);
}
__device__ __forceinline__ void add_bias(f32x16& p0, f32x16& p1, LAS const float* tab, int idx0) {
#pragma unroll
    for (int r = 0; r < 16; ++r) { const int o = idx0 + (r & 3) + 8 * (r >> 2); p0[r] += tab[o]; p1[r] += tab[o + 32]; }
}
__device__ __forceinline__ bf16x8 vfrag(LAS const unsigned char* vbuf, int c, int half, int s, int lane) {
    const int hi = lane >> 5, blk = (lane >> 4) & 1, qp = (lane & 15) >> 2, p = lane & 3;
    const int lo = 256 * qp + 8 * (p & 1) + 16 * (4 * (c ^ qp));
    const int R0 = 32 * half + 16 * s + 4 * hi;
    const int a0 = lo + 256 * R0 + 16 * ((2 * blk + (p >> 1)) ^ hi), a1 = lo + 256 * (R0 + 8) + 16 * ((2 * blk + (p >> 1)) ^ (2 + hi));
    const s16x4 x = vtr(vbuf + a0), y = vtr(vbuf + a1);
    return (bf16x8){x[0], x[1], x[2], x[3], y[0], y[1], y[2], y[3]};
}
struct TileRegs { u32x4 k0, k1, v0, v1; };
__device__ __forceinline__ void load_tile_bf16(TileRegs& R, const bf16_t* Kb, const bf16_t* Vb, size_t row0, int h, int tid, int nvalid) {
    const int row = tid >> 3, c = tid & 7;
    if (row < nvalid) { const u32x4* kp = (const u32x4*)(Kb + (row0 + row) * 1024 + h * 128); const u32x4* vp = (const u32x4*)(Vb + (row0 + row) * 1024 + h * 128);
        R.k0 = kp[c]; R.k1 = kp[c + 8]; R.v0 = vp[c]; R.v1 = vp[c + 8]; }
    else { R.k0 = R.k1 = R.v0 = R.v1 = (u32x4){0u, 0u, 0u, 0u}; }
}
__device__ __forceinline__ void store_tile_bf16(const TileRegs& R, LAS unsigned char* kbuf, LAS unsigned char* vbuf, int tid) {
    const int row = tid >> 3, c = tid & 7;
    *(LAS u32x4*)(kbuf + off_b(row, c)) = R.k0; *(LAS u32x4*)(kbuf + off_b(row, c + 8)) = R.k1;
    *(LAS u32x4*)(vbuf + off_b(row, c)) = R.v0; *(LAS u32x4*)(vbuf + off_b(row, c + 8)) = R.v1;
}
__device__ __forceinline__ void load_half_bf16(u32x4& r0, u32x4& r1, const bf16_t* B, size_t row0, int h, int tid) { const int row = tid >> 3, c = tid & 7; const u32x4* p = (const u32x4*)(B + (row0 + row) * 1024 + h * 128); r0 = p[c]; r1 = p[c + 8]; }
__device__ __forceinline__ void store_half_bf16(const u32x4& r0, const u32x4& r1, LAS unsigned char* buf, int tid) { const int row = tid >> 3, c = tid & 7; *(LAS u32x4*)(buf + off_b(row, c)) = r0; *(LAS u32x4*)(buf + off_b(row, c + 8)) = r1; }
struct TileRegsF { f32x4 k[4], v[4]; };
__device__ __forceinline__ void load_tile_f32(TileRegsF& R, const float* ck, const float* cv, int key0, int h, int tid) {
    const int pc = tid & 31;
#pragma unroll
    for (int i = 0; i < 4; ++i) { const int row = (tid >> 5) + 16 * i; const size_t o = ((size_t)(key0 + row) * NH + h) * 128 + pc * 4;
        R.k[i] = __builtin_nontemporal_load((const f32x4*)(ck + o)); R.v[i] = __builtin_nontemporal_load((const f32x4*)(cv + o)); }
}
__device__ __forceinline__ void store_tile_f32(const TileRegsF& R, LAS unsigned char* kbuf, LAS unsigned char* vbuf, int tid) {
    const int pc = tid & 31;
#pragma unroll
    for (int i = 0; i < 4; ++i) { const int row = (tid >> 5) + 16 * i; const int o = off_b(row, pc >> 1) + 8 * (pc & 1);
        u32x2 a; a.x = pk_bf16(R.k[i].x, R.k[i].y); a.y = pk_bf16(R.k[i].z, R.k[i].w); *(LAS u32x2*)(kbuf + o) = a;
        u32x2 b; b.x = pk_bf16(R.v[i].x, R.v[i].y); b.y = pk_bf16(R.v[i].z, R.v[i].w); *(LAS u32x2*)(vbuf + o) = b; }
}
__device__ __forceinline__ void stage_q(LAS unsigned char* qbuf, const bf16_t* Qb, size_t row0, int nrows, int h, int lane) {
#pragma unroll
    for (int i = 0; i < 8; ++i) { const int row = (lane >> 4) + 4 * i, ch = lane & 15; const int rr = row < nrows ? row : row % nrows;
        *(LAS u32x4*)(qbuf + off_b(row, ch)) = *(const u32x4*)(Qb + (row0 + rr) * 1024 + h * 128 + ch * 8); }
}

__device__ __forceinline__ void prompt_unit(Frame& F, int b, int h, int qb, float lam) {
    int tid_ = F.tid; asm volatile("" : "+v"(tid_));
    const int tid = tid_, lane = tid_ & 63, wid = F.wave, map = wid >> 2, qblk = wid & 3;
    LAS unsigned char* lds = F.lds; LAS float* tab = (LAS float*)(lds + TAB_OFF); LAS const float* hn = (LAS const float*)(lds + HN_OFF);
    LAS unsigned char* qbuf = lds + L_STG + wid * 8192;
    const float c15 = F.relb[15 * NH + h] * LOG2E;
    if (tid < 256) tab[tid] = F.relb[rel_bucket(tid - 192) * NH + h] * LOG2E - c15;
    const int q0w = 128 * qb + 32 * qblk, cw = 2 * qb + (qblk >> 1), NT = 2 * qb + 2;
    const size_t rowb = (size_t)b * SEQ;
    stage_q(qbuf, F.QB(), rowb + q0w, 32, h, lane);
    TileRegs R;
    load_half_bf16(R.k0, R.k1, F.KB(), rowb, h, tid); load_half_bf16(R.v0, R.v1, F.VB(), rowb, h, tid);
    store_half_bf16(R.k0, R.k1, lds + L_K, tid); store_half_bf16(R.v0, R.v1, lds + L_V, tid);
    load_half_bf16(R.k0, R.k1, F.KB(), rowb + 64, h, tid); store_half_bf16(R.k0, R.k1, lds + L_K + TILEB, tid);
    __syncthreads();
    float m = 0.f, l = 0.f; f32x16 o[4], negm;
#pragma unroll
    for (int c = 0; c < 4; ++c)
#pragma unroll
        for (int r = 0; r < 16; ++r) o[c][r] = 0.f;
#pragma unroll
    for (int r = 0; r < 16; ++r) negm[r] = c15;
    const int r32 = lane & 31, hi = lane >> 5;
    f32x16 pa0, pa1, pb0, pb1;
    qk_map(pa0, pa1, lds + L_K, qbuf, map, negm, r32, hi);
    if (-q0w > -154) add_bias(pa0, pa1, tab, -(q0w + r32) + 192 + 4 * hi);
    { const float rm = rowmax32(pa0, pa1); m = rm;
#pragma unroll
      for (int r = 0; r < 16; ++r) { pa0[r] -= rm; pa1[r] -= rm; negm[r] = c15 - rm; } }
#define PROMPT_STEP(t, P0, P1, N0, N1) do { \
        int tidl = tid; asm volatile("" : "+v"(tidl)); \
        if ((t) + 2 < NT) load_half_bf16(R.k0, R.k1, F.KB(), rowb + (size_t)((t) + 2) * 64, h, tidl); \
        if ((t) + 1 < NT) load_half_bf16(R.v0, R.v1, F.VB(), rowb + (size_t)((t) + 1) * 64, h, tidl); \
        if ((t) <= cw) { \
            LAS const unsigned char* vbuf = lds + L_V + ((t) & 1) * TILEB; \
            qk_map(N0, N1, lds + L_K + (((t) + 1) & 1) * TILEB, qbuf, map, negm, r32, hi);        \
            float s_ = 0.f; \
            _Pragma("unroll") for (int r = 0; r < 16; ++r) { P0[r] = fast_exp2(P0[r]); P1[r] = fast_exp2(P1[r]); } \
            _Pragma("unroll") for (int r = 0; r < 16; ++r) s_ += P0[r] + P1[r]; \
            __builtin_amdgcn_sched_group_barrier(0x100, 12, 0); \
            _Pragma("unroll") for (int i_ = 0; i_ < 8; ++i_) { __builtin_amdgcn_sched_group_barrier(0x8, 1, 0); __builtin_amdgcn_sched_group_barrier(0x400, 4, 0); } \
            if (__builtin_expect(__any(!(s_ <= 4096.f)), 0)) {          \
                qk_map(P0, P1, lds + L_K + ((t) & 1) * TILEB, qbuf, map, negm, r32, hi);          \
                if (64 * (t) - q0w > -154) add_bias(P0, P1, tab, 64 * (t) - (q0w + r32) + 192 + 4 * hi); \
                const float rm = rowmax32(P0, P1), dl = fmaxf(rm, 0.f); m += dl; \
                const float f = fast_exp2(-dl); l *= f; s_ = 0.f; \
                _Pragma("unroll") for (int r = 0; r < 16; ++r) { P0[r] = fast_exp2(P0[r] - dl); P1[r] = fast_exp2(P1[r] - dl); s_ += P0[r] + P1[r]; negm[r] = c15 - m; N0[r] -= dl; N1[r] -= dl; } \
                _Pragma("unroll") for (int c = 0; c < 4; ++c) _Pragma("unroll") for (int r = 0; r < 16; ++r) o[c][r] *= f; \
            } \
            l += s_; \
            if (64 * ((t) + 1) - q0w > -154) add_bias(N0, N1, tab, 64 * ((t) + 1) - (q0w + r32) + 192 + 4 * hi); \
            bf16x8 pf[2][2]; pf[0][0] = pack8(P0, 0); pf[0][1] = pack8(P0, 1); pf[1][0] = pack8(P1, 0); pf[1][1] = pack8(P1, 1); \
            _Pragma("unroll") for (int c = 0; c < 4; ++c) _Pragma("unroll") for (int half = 0; half < 2; ++half) _Pragma("unroll") for (int s = 0; s < 2; ++s) \
                o[c] = MFMA32(vfrag(vbuf, c, half, s, lane), pf[half][s], o[c]); \
        } \
        if ((t) + 2 < NT) store_half_bf16(R.k0, R.k1, lds + L_K + ((t) & 1) * TILEB, tidl); \
        if ((t) + 1 < NT) store_half_bf16(R.v0, R.v1, lds + L_V + (((t) + 1) & 1) * TILEB, tidl); \
        __syncthreads(); } while (0)
    for (int t = 0; t < NT; t += 2) {
        PROMPT_STEP(t, pa0, pa1, pb0, pb1);
        PROMPT_STEP(t + 1, pb0, pb1, pa0, pa1);
    }
#undef PROMPT_STEP
    int lane2 = lane; asm volatile("" : "+v"(lane2));
    const int r32e = lane2 & 31, hie = lane2 >> 5;
    l += __shfl_xor(l, 32);
    LAS float* xch = (LAS float*)(lds + L_STG + qblk * 16384);
    if (map == 1) { const float i2 = lam / l;
#pragma unroll
        for (int c = 0; c < 4; ++c)
#pragma unroll
            for (int r = 0; r < 16; ++r) xch[(c * 16 + r) * 64 + lane2] = o[c][r] * i2; }
    __syncthreads();
    if (map == 0) {
        const float i1 = 1.f / l; float ssq = 0.f;
#pragma unroll
        for (int c = 0; c < 4; ++c)
#pragma unroll
            for (int r = 0; r < 16; ++r) { const float v = o[c][r] * i1 - xch[(c * 16 + r) * 64 + lane2]; o[c][r] = v; ssq += v * v; }
        ssq += __shfl_xor(ssq, 32);
        const float rs = 1.f / sqrtf(ssq * (1.f / DV) + EPS);
        LAS unsigned char* ob = (LAS unsigned char*)xch;
#pragma unroll
        for (int c = 0; c < 4; ++c)
#pragma unroll
            for (int g = 0; g < 4; ++g) { const int d = 32 * c + 8 * g + 4 * hie; const f32x4 hv = *(LAS const f32x4*)(hn + d);
                u32x2 w; w.x = pk_bf16(o[c][4 * g] * rs * hv.x, o[c][4 * g + 1] * rs * hv.y); w.y = pk_bf16(o[c][4 * g + 2] * rs * hv.z, o[c][4 * g + 3] * rs * hv.w);
                *(LAS u32x2*)(ob + r32e * 256 + (((4 * c + g) ^ (r32e & 7)) * 16) + hie * 8) = w; }
#pragma unroll
        for (int i = 0; i < 8; ++i) { const int row = 4 * i + (lane2 >> 4), c16 = lane2 & 15;
            const u32x4 v = *(LAS const u32x4*)(ob + row * 256 + ((c16 ^ (row & 7)) * 16));
            bf16_t* ap = F.A3() + (rowb + q0w + row) * 2048 + h * 128 + c16 * 8; const u32x4 z = *(const u32x4*)ap;
            u32x4 w; w.x = pk_bf16(bf_lo(v.x) * bf_lo(z.x), bf_hi(v.x) * bf_hi(z.x)); w.y = pk_bf16(bf_lo(v.y) * bf_lo(z.y), bf_hi(v.y) * bf_hi(z.y));
            w.z = pk_bf16(bf_lo(v.z) * bf_lo(z.z), bf_hi(v.z) * bf_hi(z.z)); w.w = pk_bf16(bf_lo(v.w) * bf_lo(z.w), bf_hi(v.w) * bf_hi(z.w));
            *(u32x4*)ap = w; }
    }
    __syncthreads();
}

__device__ __forceinline__ void sample_unit(Frame& F, int b, int h, float lam) {
    int tid_ = F.tid; asm volatile("" : "+v"(tid_));
    const int tid = tid_, lane = tid_ & 63, wid = F.wave, r32 = lane & 31, hi = lane >> 5, map = wid >> 2, c = wid & 3;
    LAS unsigned char* lds = F.lds; LAS float* tab = (LAS float*)(lds + TAB_OFF); LAS const float* hn = (LAS const float*)(lds + HN_OFF);
    LAS unsigned char* qbuf = lds + L_STG + wid * 8192;
    const float c15 = F.relb[15 * NH + h] * LOG2E;
    if (tid < 256) tab[tid] = F.relb[rel_bucket(tid - 192) * NH + h] * LOG2E - c15;
    const size_t rowq = (size_t)MP + (size_t)b * DEC_SEQ;
    stage_q(qbuf, F.QB(), rowq, 16, h, lane);
    const float* ck = F.ck + (size_t)b * PAST * NH * 128; const float* cv = F.cv + (size_t)b * PAST * NH * 128;
    constexpr int NTC = PAST / 64;
    float m = 0.f, l = 0.f; f32x16 o[1], negm;
#pragma unroll
    for (int r = 0; r < 16; ++r) { o[0][r] = 0.f; negm[r] = c15; }
#define SAMPLE_TILE(t) do { \
        int lane_ = lane; asm volatile("" : "+v"(lane_)); \
        const int r32_ = lane_ & 31, hi_ = lane_ >> 5, qi_ = r32_ & 15; \
        LAS const unsigned char* kbuf = lds + L_K + ((t) & 1) * TILEB; LAS const unsigned char* vbuf = lds + L_V + ((t) & 1) * TILEB; \
        const bool near = ((t) >= 30), first = ((t) == 0); \
        f32x16 p0, p1; \
        qk_map(p0, p1, kbuf, qbuf, map, negm, r32_, hi_); \
        if (near) add_bias(p0, p1, tab, 64 * (t) - (PAST + qi_) + 192 + 4 * hi_); \
        if ((t) == NTC) { _Pragma("unroll") for (int r = 0; r < 16; ++r) { if (crow(r, hi_) >= DEC_SEQ) p0[r] = -__builtin_inff(); p1[r] = -__builtin_inff(); } } \
        softmax_tile<1>(p0, p1, m, l, o, negm, c15, first); \
        const bf16x8 pf00 = pack8(p0, 0), pf01 = pack8(p0, 1), pf10 = pack8(p1, 0), pf11 = pack8(p1, 1); \
        o[0] = MFMA32(vfrag(vbuf, c, 0, 0, lane_), pf00, o[0]); o[0] = MFMA32(vfrag(vbuf, c, 0, 1, lane_), pf01, o[0]); \
        o[0] = MFMA32(vfrag(vbuf, c, 1, 0, lane_), pf10, o[0]); o[0] = MFMA32(vfrag(vbuf, c, 1, 1, lane_), pf11, o[0]); } while (0)
    TileRegsF R0, R1;
    load_tile_f32(R0, ck, cv, 0, h, tid); load_tile_f32(R1, ck, cv, 64, h, tid);
    store_tile_f32(R0, lds + L_K, lds + L_V, tid); load_tile_f32(R0, ck, cv, 128, h, tid);
    __syncthreads();
    for (int t = 0; t < NTC; t += 2) {
        SAMPLE_TILE(t);
        store_tile_f32(R1, lds + L_K + TILEB, lds + L_V + TILEB, tid);
        if (t + 3 < NTC) load_tile_f32(R1, ck, cv, (t + 3) * 64, h, tid);
        __syncthreads();
        SAMPLE_TILE(t + 1);
        if (t + 2 < NTC) { store_tile_f32(R0, lds + L_K, lds + L_V, tid); if (t + 4 < NTC) load_tile_f32(R0, ck, cv, (t + 4) * 64, h, tid); }
        else { TileRegs RN; load_tile_bf16(RN, F.KB(), F.VB(), rowq, h, tid, DEC_SEQ); store_tile_bf16(RN, lds + L_K, lds + L_V, tid); }
        __syncthreads();
    }
    SAMPLE_TILE(NTC);
    __syncthreads();
#undef SAMPLE_TILE
    l += __shfl_xor(l, 32);
    const float inv = 1.f / l;
    LAS float* stg = (LAS float*)(lds + L_K);
    if (r32 < 16) {
#pragma unroll
        for (int g = 0; g < 4; ++g) { const f32x4 v = {o[0][4 * g] * inv, o[0][4 * g + 1] * inv, o[0][4 * g + 2] * inv, o[0][4 * g + 3] * inv};
            *(LAS f32x4*)(stg + (map * 16 + r32) * 128 + 32 * c + 8 * g + 4 * hi) = v; }
    }
    __syncthreads();
    {
        const int q = tid >> 5, d4 = (tid & 31) * 4;
        const f32x4 s1 = *(LAS const f32x4*)(stg + q * 128 + d4), s2 = *(LAS const f32x4*)(stg + (16 + q) * 128 + d4);
        f32x4 v = s1 - s2 * lam; float ssq = (v.x * v.x + v.y * v.y) + (v.z * v.z + v.w * v.w);
#pragma unroll
        for (int x = 1; x < 32; x <<= 1) ssq += __shfl_xor(ssq, x);
        const float rs = 1.f / sqrtf(ssq * (1.f / DV) + EPS); const f32x4 hv = *(LAS const f32x4*)(hn + d4);
        bf16_t* ap = F.A3() + (rowq + q) * 2048 + h * 128 + d4; const u32x2 z = *(const u32x2*)ap;
        u32x2 w; w.x = pk_bf16(v.x * rs * hv.x * bf_lo(z.x), v.y * rs * hv.y * bf_hi(z.x)); w.y = pk_bf16(v.z * rs * hv.z * bf_lo(z.y), v.w * rs * hv.w * bf_hi(z.y));
        *(u32x2*)ap = w;
    }
    __syncthreads();
}
#undef MFMA32
}

__device__ __forceinline__ void unpack8(const u32x4 w, float (&f)[8]) { f[0] = bf_lo(w.x); f[1] = bf_hi(w.x); f[2] = bf_lo(w.y); f[3] = bf_hi(w.y); f[4] = bf_lo(w.z); f[5] = bf_hi(w.z); f[6] = bf_lo(w.w); f[7] = bf_hi(w.w); }
__device__ __forceinline__ void conv_phase(Frame& F, int widx, int nwg) {
    const int NTH = nwg * NWAVES * 64; const int gt = widx * (NWAVES * 64) + F.tid;
    const bf16_t* U = F.U(); bf16_t* A3 = F.A3();
    for (int it = gt; it < (M / 8) * 128; it += NTH) {
        const int row0 = (it >> 7) * 8, c8 = (it & 127) * 8;
        int t0, T; const float* st = nullptr; float* oc;
        if (row0 < MP) { t0 = row0 & (SEQ - 1); T = SEQ; oc = F.out + O_CP + (size_t)(row0 >> 11) * 2 * CONV_W; }
        else { const int sr = row0 - MP; t0 = sr & (DEC_SEQ - 1); T = DEC_SEQ; st = F.sconv + (size_t)(sr >> 4) * 2 * CONV_W; oc = F.out + O_CS + (size_t)(sr >> 4) * 2 * CONV_W; }
        u32x4 uw[10], gw[8];
#pragma unroll
        for (int i = 0; i < 8; ++i) { uw[i + 2] = *(const u32x4*)(U + (size_t)(row0 + i) * 1024 + c8); gw[i] = *(const u32x4*)(A3 + (size_t)(row0 + i) * 2048 + 1024 + c8); }
        float um2[8], um1[8];
        if (t0 >= 2) { uw[0] = *(const u32x4*)(U + (size_t)(row0 - 2) * 1024 + c8); uw[1] = *(const u32x4*)(U + (size_t)(row0 - 1) * 1024 + c8); unpack8(uw[0], um2); unpack8(uw[1], um1); }
        else if (st) { const f32x4 a = *(const f32x4*)(st + c8), b = *(const f32x4*)(st + c8 + 4), c = *(const f32x4*)(st + CONV_W + c8), d = *(const f32x4*)(st + CONV_W + c8 + 4);
            um2[0] = a.x; um2[1] = a.y; um2[2] = a.z; um2[3] = a.w; um2[4] = b.x; um2[5] = b.y; um2[6] = b.z; um2[7] = b.w; um1[0] = c.x; um1[1] = c.y; um1[2] = c.z; um1[3] = c.w; um1[4] = d.x; um1[5] = d.y; um1[6] = d.z; um1[7] = d.w; }
        else {
#pragma unroll
            for (int e = 0; e < 8; ++e) { um2[e] = 0.f; um1[e] = 0.f; } }
        float w0[8], w1[8], w2[8];
        { const f32x4 a = *(const f32x4*)(F.convw + c8), b = *(const f32x4*)(F.convw + c8 + 4); w0[0] = a.x; w0[1] = a.y; w0[2] = a.z; w0[3] = a.w; w0[4] = b.x; w0[5] = b.y; w0[6] = b.z; w0[7] = b.w; }
        { const f32x4 a = *(const f32x4*)(F.convw + CONV_W + c8), b = *(const f32x4*)(F.convw + CONV_W + c8 + 4); w1[0] = a.x; w1[1] = a.y; w1[2] = a.z; w1[3] = a.w; w1[4] = b.x; w1[5] = b.y; w1[6] = b.z; w1[7] = b.w; }
        { const f32x4 a = *(const f32x4*)(F.convw + 2 * CONV_W + c8), b = *(const f32x4*)(F.convw + 2 * CONV_W + c8 + 4); w2[0] = a.x; w2[1] = a.y; w2[2] = a.z; w2[3] = a.w; w2[4] = b.x; w2[5] = b.y; w2[6] = b.z; w2[7] = b.w; }
#pragma unroll
        for (int i = 0; i < 8; ++i) {
            float uc[8], gg[8], y[8]; unpack8(uw[i + 2], uc); unpack8(gw[i], gg);
#pragma unroll
            for (int e = 0; e < 8; ++e) y[e] = gg[e] * (w0[e] * um2[e] + w1[e] * um1[e] + w2[e] * uc[e]);
            u32x4 w; w.x = pk_bf16(y[0], y[1]); w.y = pk_bf16(y[2], y[3]); w.z = pk_bf16(y[4], y[5]); w.w = pk_bf16(y[6], y[7]); *(u32x4*)(A3 + (size_t)(row0 + i) * 2048 + 1024 + c8) = w;
            const int t = t0 + i;
            if (t >= T - 2) { float* op = oc + (size_t)(t - (T - 2)) * CONV_W + c8; *(f32x4*)op = (f32x4){uc[0], uc[1], uc[2], uc[3]}; *(f32x4*)(op + 4) = (f32x4){uc[4], uc[5], uc[6], uc[7]}; }
#pragma unroll
            for (int e = 0; e < 8; ++e) { um2[e] = um1[e]; um1[e] = uc[e]; }
        }
    }
}
__device__ __forceinline__ void p2_attention(Frame& F) {
    float s1 = 0.f, s2 = 0.f;
    for (int i = 0; i < DQK; ++i) { s1 += F.lq1[i] * F.lk1[i]; s2 += F.lq2[i] * F.lk2[i]; }
    const float lam = expf(s1) - expf(s2) + LAM_INIT;
    if (F.tid < DV) ((LAS float*)(F.lds + HN_OFF))[F.tid] = F.hnorm[F.tid] * (1.f - LAM_INIT);
    __syncthreads();
    if (F.G == 256) {
        const int bx = blockIdx.x, idx = bx >> 3, gi = (bx & 7) * 16 + (idx >> 1);
        if ((idx & 1) == 0) {
            if (F.mode == 0 || F.mode == 1) for (int i = 0; i < 2; ++i) att::sample_unit(F, gi >> 2, (2 * gi + i) & 7, lam);
        } else {
            if (F.mode == 0 || F.mode == 2 || F.mode == 3) conv_phase(F, gi, 128);
            const int bh = gi >> 2, sq = gi & 3;
            if (F.mode == 0 || F.mode == 2) for (int i = 0; i < 4; ++i) { const int qb = (i == 0) ? 15 - sq : (i == 1) ? 8 + sq : (i == 2) ? 7 - sq : sq; att::prompt_unit(F, bh >> 3, bh & 7, qb, lam); }
        }
    } else {
        conv_phase(F, F.vcu, F.G);
        for (int u = F.vcu; u < DEC_BATCH * NH; u += F.G) att::sample_unit(F, u >> 3, u & 7, lam);
        for (int u = F.vcu; u < BATCH * NH * 16; u += F.G) { const int bh = u >> 4, sq = u & 15; att::prompt_unit(F, bh >> 3, bh & 7, sq, lam); }
    }
}
__device__ __forceinline__ void p5_post(Frame& F) {
    const int gw = F.vcu * NWAVES + F.wave, NGW = F.G * NWAVES;
    for (int m = gw; m < M; m += NGW) {
        const GAS u32x4* yr = (const GAS u32x4*)(F.Y() + (size_t)m * D_MODEL) + F.lane;
        const float* xrow = (m < MP) ? F.xp + (size_t)m * D_MODEL : F.xs + (size_t)(m - MP) * D_MODEL;
        float* orow = (m < MP) ? F.out + O_YP + (size_t)m * D_MODEL : F.out + O_YS + (size_t)(m - MP) * D_MODEL;
        u32x4 yw[4]; f32x4 xv[4][2]; float s = 0.f;
#pragma unroll
        for (int j = 0; j < 4; ++j) { yw[j] = yr[64 * j]; const GAS f32x4* xr = (const GAS f32x4*)(xrow + 512 * j + 8 * F.lane); xv[j][0] = xr[0]; xv[j][1] = xr[1]; }
        float y[4][8];
#pragma unroll
        for (int j = 0; j < 4; ++j) { y[j][0] = bf_lo(yw[j].x); y[j][1] = bf_hi(yw[j].x); y[j][2] = bf_lo(yw[j].y); y[j][3] = bf_hi(yw[j].y); y[j][4] = bf_lo(yw[j].z); y[j][5] = bf_hi(yw[j].z); y[j][6] = bf_lo(yw[j].w); y[j][7] = bf_hi(yw[j].w);
#pragma unroll
            for (int e = 0; e < 8; ++e) s += y[j][e] * y[j][e]; }
        const float rs = 1.f / sqrtf(wave_sum(s) * (1.f / D_MODEL) + EPS);
#pragma unroll
        for (int j = 0; j < 4; ++j) { const GAS f32x4* gr = (const GAS f32x4*)(F.npost + 512 * j + 8 * F.lane); const f32x4 g0 = gr[0], g1 = gr[1];
            GAS f32x4* op = (GAS f32x4*)(orow + 512 * j + 8 * F.lane);
            op[0] = xv[j][0] + (f32x4){y[j][0], y[j][1], y[j][2], y[j][3]} * rs * g0; op[1] = xv[j][1] + (f32x4){y[j][4], y[j][5], y[j][6], y[j][7]} * rs * g1; }
    }
}

constexpr int N_LAUNCHES = MK_N_LAUNCHES, PER_PHASE = 6;
struct Args { const float* in[18]; float* out; unsigned char* ws; int ph_lo, ph_hi, li, pad; };
__global__ void __launch_bounds__(NWAVES * 64, 2) mk_fwd(Args args) {
    extern __shared__ __attribute__((aligned(16))) unsigned char lds[];
    Frame F;
    F.lds = (LAS unsigned char*)lds;
    F.MISC = (volatile LAS unsigned*)(F.lds + MISC_OFF);
    F.tid = threadIdx.x; F.lane = F.tid & 63; F.wave = __builtin_amdgcn_readfirstlane(F.tid >> 6);
    F.mode = args.pad; F.G = gridDim.x; { const int bx = blockIdx.x; F.vcu = (F.G % 8 == 0) ? (bx % 8) * (F.G / 8) + bx / 8 : bx; }
    unsigned char* ws = args.ws;
    F.ctl = (gu32*)(ws + WS_CTL);
    F.xp = args.in[0]; F.xs = args.in[1]; F.ck = args.in[2]; F.cv = args.in[3]; F.sconv = args.in[4]; F.npre = args.in[5]; F.npost = args.in[6]; F.w_in = args.in[7];
    F.lq1 = args.in[8]; F.lk1 = args.in[9]; F.lq2 = args.in[10]; F.lk2 = args.in[11]; F.hnorm = args.in[12]; F.convw = args.in[13]; F.wpa = args.in[14]; F.wpc = args.in[15];
    F.wout = args.in[16]; F.relb = args.in[17]; F.out = args.out;
    F.ws = ws;
    for (int u = F.tid; u < 512 / 4; u += NWAVES * 64) ((LAS unsigned*)(F.lds + LDSCTL_OFF))[u] = 0u;
    __syncthreads();
    XcdBarrier bar; bar.bar = (unsigned*)(F.ctl + CW_BAR); bar.x = 0; bar.st = nullptr;
    if (N_LAUNCHES != PER_PHASE) bar = xcd_barrier_post((unsigned*)(F.ctl + CW_BAR) + args.li * XCD_BAR_WORDS, F.MISC + 8);
#define GRID_BAR() do { if (N_LAUNCHES != PER_PHASE) xcd_barrier(bar); } while (0)
    const int lo = args.ph_lo, hi = args.ph_hi;
#ifndef PH_MASK
#define PH_MASK 63
#endif
#define IN(k) (((PH_MASK >> (k)) & 1) && lo <= (k) && (k) < hi)
#define BOTH(k) (IN(k) && IN((k) + 1))
    if (IN(0)) { p0_prologue(F); if (BOTH(0)) GRID_BAR(); }
    if (IN(1)) {
        pg8::Gemm g{F.XN(), F.W1T(), M, N_IN, D_MODEL}; pg8::StaticOrder S; S.init(M, N_IN, F.G, (int)blockIdx.x);
        pg8::Epi1 E{F.QB(), F.KB(), F.VB(), F.A3(), F.U(), F.RB(), F.S2(), F.out};
        pg8::gemm_phase<pg8::Epi1, pg8::StaticOrder, true, true>(F.lds, g, S, E);
        if (BOTH(1)) GRID_BAR();
    }
    if (IN(2)) { p2_attention(F); if (BOTH(2)) GRID_BAR(); }
    if (IN(3)) {
        pg8::Gemm g{F.A3(), F.W3T(), M, D_MODEL, D_MODEL}; pg8::StaticOrder S; S.init(M, D_MODEL, F.G, (int)blockIdx.x);
        pg8::Epi3 E{F.RB(), F.S2(), F.MB()};
        S.limit = (S.nwg / F.G) * F.G;
        pg8::gemm_phase<pg8::Epi3, pg8::StaticOrder, true, true>(F.lds, g, S, E);
        if (F.mode != 4) pg8::gemm_tail<pg8::Epi3>(F.lds, g, S, E);
        if (BOTH(3)) GRID_BAR();
    }
    if (IN(4)) {
        pg8::Gemm g{F.MB(), F.W4T(), M, D_MODEL, D_MODEL}; pg8::StaticOrder S; S.init(M, D_MODEL, F.G, (int)blockIdx.x);
        pg8::EpiY E{F.Y()};
        S.limit = (S.nwg / F.G) * F.G;
        pg8::gemm_phase<pg8::EpiY, pg8::StaticOrder, true, true>(F.lds, g, S, E);
        if (F.mode != 4) pg8::gemm_tail<pg8::EpiY>(F.lds, g, S, E);
        if (BOTH(4)) GRID_BAR();
    }
    if (IN(5)) { p5_post(F); }
#undef IN
#undef BOTH
}

extern "C" void kernel_launch(void* const* d_in, const int* in_sizes, int n_in, void* d_out, int out_size, void* d_ws, size_t ws_size, hipStream_t stream) {
    static int grid = 0;
    if (grid == 0) {
        if (n_in != 18 || (size_t)out_size != O_END || ws_size < WS_END) { fprintf(stderr, "kernel_launch: unexpected sizes n_in %d out %d ws %zu\n", n_in, out_size, ws_size); grid = -1; return; }
        int dev = 0, cus = 0, per_cu = 0;
        if (hipGetDevice(&dev) != hipSuccess || hipDeviceGetAttribute(&cus, hipDeviceAttributeMultiprocessorCount, dev) != hipSuccess) { grid = -1; return; }
        if (hipFuncSetAttribute((const void*)mk_fwd, hipFuncAttributeMaxDynamicSharedMemorySize, LDS_BYTES) != hipSuccess) { fprintf(stderr, "kernel_launch: hipFuncSetAttribute failed\n"); grid = -1; return; }
        if (hipOccupancyMaxActiveBlocksPerMultiprocessor(&per_cu, (const void*)mk_fwd, NWAVES * 64, LDS_BYTES) != hipSuccess || per_cu < 1) { fprintf(stderr, "kernel_launch: occupancy query says %d\n", per_cu); (void)hipGetLastError(); grid = -1; return; }
        grid = cus;
    }
    if (grid < 0) return;
    (void)hipMemsetAsync((char*)d_ws + WS_CTL, 0, CTL_ZERO_BYTES, stream);
    Args a{};
    for (int i = 0; i < 18; ++i) a.in[i] = (const float*)d_in[i];
    a.out = (float*)d_out; a.ws = (unsigned char*)d_ws;
    for (int li = 0; li < N_LAUNCHES; ++li) {
        a.ph_lo = (N_LAUNCHES == PER_PHASE) ? li : 0; a.ph_hi = (N_LAUNCHES == PER_PHASE) ? li + 1 : PER_PHASE; a.li = li;
        hipLaunchKernelGGL(mk_fwd, dim3(grid), dim3(NWAVES * 64), LDS_BYTES, stream, a);
    }
#if PROBE_LO >= 0
    a.ph_lo = PROBE_LO; a.ph_hi = PROBE_HI; a.li = 1; a.pad = PROBE_MODE;
    hipLaunchKernelGGL(mk_fwd, dim3(grid), dim3(NWAVES * 64), LDS_BYTES, stream, a);
#endif
}
```
